# Optimizing an MI355X kernel written in HIP

```python
import jax, jax.numpy as jnp
from jax import lax
import numpy as np

D_MODEL = 1024
BATCH = 8
SEQ = 2048
DEPTH = 4

N_MIXERS = 2
CHUNK = 128
GMLP_WIDTH = 2 * D_MODEL
GMLP_GROUPS = 8
GMLP_GROUP_DIM = GMLP_WIDTH // GMLP_GROUPS
FOX_HEAD_DIM = 64
FOX_HEADS = D_MODEL // FOX_HEAD_DIM
FOX_WIDTH = FOX_HEADS * FOX_HEAD_DIM
Q_BLOCK = 128
D_FF = 4 * D_MODEL
N_GMLP = (DEPTH + 1) // 2
N_FOX = DEPTH // 2
RMS_EPS = 1e-6
LN_EPS = 1e-5

kernel_name = "hybrid_gmlp_fox_sqrelu_trunk"


def rms_norm(x, g):
    xf = x.astype(jnp.float32)
    y = xf * lax.rsqrt(jnp.mean(xf * xf, axis=-1, keepdims=True) + RMS_EPS)
    return (y * g.astype(jnp.float32)).astype(x.dtype)


def layer_norm(x, g, b):
    xf = x.astype(jnp.float32)
    mu = jnp.mean(xf, axis=-1, keepdims=True)
    xc = xf - mu
    var = jnp.mean(xc * xc, axis=-1, keepdims=True)
    y = xc * lax.rsqrt(var + LN_EPS) * g.astype(jnp.float32) + b.astype(jnp.float32)
    return y.astype(x.dtype)


def gmlp_mixer(h, w_in, ln_g, ln_b, w_s, b_s, w_out):
    B, S, _ = h.shape
    z = jax.nn.gelu(h @ w_in)
    u, v = jnp.split(z, 2, axis=-1)
    v = layer_norm(v, ln_g, ln_b)
    v = v.reshape(B, S // CHUNK, CHUNK, GMLP_GROUPS, GMLP_GROUP_DIM)
    causal = jnp.tril(jnp.ones((CHUNK, CHUNK), dtype=bool))
    w = jnp.where(causal[None], w_s, jnp.zeros((), w_s.dtype))
    s = jnp.einsum('gts,bnsgc->bntgc', w, v) + b_s.T[None, None, :, :, None]
    out = u * s.reshape(B, S, GMLP_WIDTH)
    return out @ w_out


def fox_mixer(h, w_in, b_f, q_g, k_g, w_out):
    B, S, _ = h.shape
    W, H, Dh = FOX_WIDTH, FOX_HEADS, FOX_HEAD_DIM
    p = h @ w_in
    q, k, v, gate, f_logit = jnp.split(p, [W, 2 * W, 3 * W, 4 * W], axis=-1)
    q = rms_norm(q.reshape(B, S, H, Dh), q_g).transpose(0, 2, 1, 3)
    k = rms_norm(k.reshape(B, S, H, Dh), k_g).transpose(0, 2, 1, 3)
    v = v.reshape(B, S, H, Dh).transpose(0, 2, 1, 3)
    log_f = jax.nn.log_sigmoid((f_logit + b_f).astype(jnp.float32))
    c = jnp.cumsum(log_f, axis=1).transpose(0, 2, 1)
    scale = Dh ** -0.5
    outs = []
    for i in range(S // Q_BLOCK):
        q0 = i * Q_BLOCK
        kend = q0 + Q_BLOCK
        qb = q[:, :, q0:kend]
        kb = k[:, :, :kend]
        vb = v[:, :, :kend]
        logits = jnp.einsum('bhtd,bhsd->bhts', qb, kb).astype(jnp.float32) * scale
        logits = logits + c[:, :, q0:kend, None] - c[:, :, None, :kend]
        t_idx = q0 + jnp.arange(Q_BLOCK)[:, None]
        s_idx = jnp.arange(kend)[None, :]
        logits = jnp.where(t_idx >= s_idx, logits, -jnp.inf)
        probs = jax.nn.softmax(logits, axis=-1).astype(vb.dtype)
        outs.append(jnp.einsum('bhts,bhsd->bhtd', probs, vb))
    o = jnp.concatenate(outs, axis=2).transpose(0, 2, 1, 3).reshape(B, S, W)
    o = o * jax.nn.sigmoid(gate)
    return o @ w_out


def sqrelu_mlp(h, w1, w2):
    return jnp.square(jax.nn.relu(h @ w1)) @ w2


def setup_inputs(seed: int = 0) -> dict:
    key = jax.random.key(seed)
    ks = jax.random.split(key, 20)
    f32 = jnp.float32
    D, E, G, W, H, Dh = D_MODEL, GMLP_WIDTH, GMLP_GROUPS, FOX_WIDTH, FOX_HEADS, FOX_HEAD_DIM
    nrm = lambda k, shape, s: jax.random.normal(k, shape, f32) * s
    x = nrm(ks[0], (BATCH, SEQ, D), 1.0)
    gmlp_w_in = nrm(ks[1], (N_GMLP, D, 2 * E), D ** -0.5)
    gmlp_ln_g = 1.0 + nrm(ks[2], (N_GMLP, E), 0.02)
    gmlp_ln_b = nrm(ks[3], (N_GMLP, E), 0.02)
    gmlp_w_s = nrm(ks[4], (N_GMLP, G, CHUNK, CHUNK), CHUNK ** -0.5)
    gmlp_b_s = 1.0 + nrm(ks[5], (N_GMLP, G, CHUNK), 0.1)
    gmlp_w_out = nrm(ks[6], (N_GMLP, E, D), E ** -0.5)
    fox_w_in = nrm(ks[7], (N_FOX, D, 4 * W + H), D ** -0.5)
    fox_b_f = jnp.linspace(0.0, 4.0, H, dtype=f32)[None, :] + nrm(ks[8], (N_FOX, H), 0.1)
    fox_q_g = 1.0 + nrm(ks[9], (N_FOX, Dh), 0.02)
    fox_k_g = 1.0 + nrm(ks[10], (N_FOX, Dh), 0.02)
    fox_w_out = nrm(ks[11], (N_FOX, W, D), W ** -0.5)
    mix_norm_g = 1.0 + nrm(ks[12], (DEPTH, D), 0.02)
    mlp_norm_g = 1.0 + nrm(ks[13], (DEPTH, D), 0.02)
    mlp_w1 = nrm(ks[14], (DEPTH, D, D_FF), D ** -0.5)
    mlp_w2 = nrm(ks[15], (DEPTH, D_FF, D), D_FF ** -0.5)
    return {"x": x, "gmlp_w_in": gmlp_w_in, "gmlp_ln_g": gmlp_ln_g, "gmlp_ln_b": gmlp_ln_b,
            "gmlp_w_s": gmlp_w_s, "gmlp_b_s": gmlp_b_s, "gmlp_w_out": gmlp_w_out,
            "fox_w_in": fox_w_in, "fox_b_f": fox_b_f, "fox_q_g": fox_q_g, "fox_k_g": fox_k_g,
            "fox_w_out": fox_w_out, "mix_norm_g": mix_norm_g, "mlp_norm_g": mlp_norm_g,
            "mlp_w1": mlp_w1, "mlp_w2": mlp_w2}


def reference(x, gmlp_w_in, gmlp_ln_g, gmlp_ln_b, gmlp_w_s, gmlp_b_s, gmlp_w_out,
              fox_w_in, fox_b_f, fox_q_g, fox_k_g, fox_w_out,
              mix_norm_g, mlp_norm_g, mlp_w1, mlp_w2):
    for i in range(DEPTH):
        h = rms_norm(x, mix_norm_g[i])
        j = i // N_MIXERS
        if i % N_MIXERS == 0:
            x = x + gmlp_mixer(h, gmlp_w_in[j], gmlp_ln_g[j], gmlp_ln_b[j],
                               gmlp_w_s[j], gmlp_b_s[j], gmlp_w_out[j])
        else:
            x = x + fox_mixer(h, fox_w_in[j], fox_b_f[j], fox_q_g[j], fox_k_g[j], fox_w_out[j])
        h = rms_norm(x, mlp_norm_g[i])
        x = x + sqrelu_mlp(h, mlp_w1[i], mlp_w2[i])
    return x
```

```cpp
#include <hip/hip_runtime.h>
#include <hip/hip_cooperative_groups.h>
#include <cstdio>
#include <cstdint>
#ifndef PG8_SP2
#define PG8_SP2 true
#endif
#ifndef PG8_ALIGN
#define PG8_ALIGN true
#endif
#ifndef MK_ONE_LAUNCH
#define MK_ONE_LAUNCH 1
#endif
#ifndef RP_P0
#define RP_P0 1
#endif
#ifndef RP_NORM
#define RP_NORM 1
#endif
#ifndef RP_G4
#define RP_G4 1
#endif
#ifndef RP_ATT
#define RP_ATT 1
#endif
#ifndef RP_SP
#define RP_SP 1
#endif
#ifndef RP_FIX
#define RP_FIX 1
#endif
#ifndef RP_RES
#define RP_RES 1
#endif
#ifndef RP_BAR
#define RP_BAR 0
#endif
namespace pg8 {
#define PG8_LAS __attribute__((address_space(3)))
typedef unsigned short bf16_t;
typedef short bf16x8 __attribute__((ext_vector_type(8)));
typedef float f32x4 __attribute__((ext_vector_type(4)));
typedef unsigned u32x4 __attribute__((ext_vector_type(4)));
constexpr int BM = 256, BK = 64, HALF = 128, HTB = HALF * BK * 2  , STAGE_BYTES = 8 * HTB, NXCD = 8, WGM = 8;

__host__ __device__ __forceinline__ int lds_byte(int r, int c) { const int st = (r >> 4) * 2 + (c >> 5), rr = r & 15, cc = c & 31, ob = rr * 64 + cc * 2; return st * 1024 + (ob ^ (((ob >> 9) & 1) << 5)); }
__host__ __device__ __forceinline__ void stage_rc(int b, int& R, int& C) { const int st = b / 1024, sb = b % 1024, swz = sb ^ (((sb >> 9) & 1) << 5); R = (st >> 1) * 16 + swz / 64; C = (st & 1) * 32 + (swz % 64) / 2; }
__host__ __device__ __forceinline__ int perm32(int rho) { const int n = rho >> 4, i = rho & 15; return 8 * (i >> 2) + 4 * n + (i & 3); }

struct Unit { int pm, pn; };
struct Gemm { const bf16_t* A; const bf16_t* Bt; int M, N, K, lda; size_t abx; };

struct StaticOrder {
    int nM, nN, nwg, G, c;
    __host__ __device__ __forceinline__ void init(int M, int N, int G_, int c_) { nM = M / BM; nN = N / BM; nwg = nM * nN; G = G_; c = c_; }
    __host__ __device__ __forceinline__ bool next(int i, Unit& u) const {
        const long L = (long)i * G + c; if (L >= nwg) return false;
        int wgid = (int)L; { const int q = nwg / NXCD, r = nwg % NXCD, xcd = wgid % NXCD, off = wgid / NXCD; wgid = (xcd < r ? xcd * (q + 1) : r * (q + 1) + (xcd - r) * q) + off; }
        const int nig = WGM * nN, gid = wgid / nig, fm = gid * WGM, gsz = (nM - fm) < WGM ? (nM - fm) : WGM;
        u.pm = fm + ((wgid % nig) % gsz); u.pn = (wgid % nig) / gsz; return true;
    }
    __device__ __forceinline__ void a_ready(const Unit&) const {}
    __device__ __forceinline__ void done(const Unit&) const {}
};
__device__ __forceinline__ unsigned cvt_pk_bf16(float lo, float hi) { unsigned r; asm volatile("v_cvt_pk_bf16_f32 %0, %1, %2" : "=v"(r) : "v"(lo), "v"(hi)); return r; }
__device__ __forceinline__ float fq_sum(float v) {
    { const auto r = __builtin_amdgcn_permlane16_swap(__float_as_uint(v), __float_as_uint(v), false, false); v = __uint_as_float(r[0]) + __uint_as_float(r[1]); }
    { const auto r = __builtin_amdgcn_permlane32_swap(__float_as_uint(v), __float_as_uint(v), false, false); v = __uint_as_float(r[0]) + __uint_as_float(r[1]); }
    return v;
}
__device__ __forceinline__ float gelu_tanh(float x) {
    const float u = x * (1.0f + 0.044715f * x * x);
    const float e = __builtin_amdgcn_exp2f(-2.3022081985f * u);
    return x * __builtin_amdgcn_rcpf(1.0f + e);
}
typedef float f32x2 __attribute__((ext_vector_type(2)));
template <int ACT> struct EpiBf16 {
    static constexpr bool PERM = true, AFTER_DRAIN = false, HAS_INIT = false, HAS_PRE = true;
    bf16_t* O; int ldc; int split_cols; size_t split_stride; float* stats; int stats_pn0; const float* xs; const PG8_LAS float* rsl; int rs_pm;
    f32x4 rs_raw; PG8_LAS float* rsl_w;
    __device__ __forceinline__ void pre(int tid) const { if (tid < BM) rsl_w[tid] = 1.0f / sqrtf(((rs_raw[0] + rs_raw[1]) + (rs_raw[2] + rs_raw[3])) * (1.0f / 1024.0f) + 1e-6f); }
    __device__ __forceinline__ void operator()(const f32x4 (&acc)[2][2][4][2], const Unit& u, int wr, int wc, int fr, int fq) const {
        const int row0 = u.pm * BM + wr * 64 + fr; int colt = u.pn * BM; bf16_t* base = O;
        if (split_cols) { const int t = colt / split_cols; base += (size_t)t * split_stride; colt -= t * split_cols; }
        const int col0 = colt + wc * 32 + 8 * fq;
        const bool do_stats = (ACT == 1) && (u.pn >= stats_pn0);
        float rsv[2][4];
        if (u.pm == rs_pm) {
#pragma unroll
          for (int ai = 0; ai < 2; ++ai)
#pragma unroll
            for (int m = 0; m < 4; ++m) rsv[ai][m] = rsl[wr * 64 + fr + ai * HALF + m * 16];
        } else { f32x4 xq[2][4];
#pragma unroll
          for (int ai = 0; ai < 2; ++ai)
#pragma unroll
            for (int m = 0; m < 4; ++m) xq[ai][m] = *(const f32x4*)(xs + (size_t)(row0 + ai * HALF + m * 16) * 4);
#pragma unroll
          for (int ai = 0; ai < 2; ++ai)
#pragma unroll
            for (int m = 0; m < 4; ++m) rsv[ai][m] = 1.0f / sqrtf(((xq[ai][m][0] + xq[ai][m][1]) + (xq[ai][m][2] + xq[ai][m][3])) * (1.0f / 1024.0f) + 1e-6f); }
#pragma unroll
        for (int ai = 0; ai < 2; ++ai)
#pragma unroll
            for (int m = 0; m < 4; ++m) { const int row = row0 + ai * HALF + m * 16; bf16_t* rowp = base + (size_t)row * ldc + col0; float s1 = 0.f, s2 = 0.f;
                const float rs = rsv[ai][m];
#pragma unroll
                for (int bj = 0; bj < 2; ++bj) { f32x4 v0 = acc[ai][bj][m][0] * rs, v1 = acc[ai][bj][m][1] * rs;
                    if (ACT == 1) {
#pragma unroll
                        for (int e = 0; e < 4; ++e) { v0[e] = gelu_tanh(v0[e]); v1[e] = gelu_tanh(v1[e]); }
                        s1 += ((v0[0] + v0[1]) + (v0[2] + v0[3])) + ((v1[0] + v1[1]) + (v1[2] + v1[3]));
                        s2 += ((v0[0] * v0[0] + v0[1] * v0[1]) + (v0[2] * v0[2] + v0[3] * v0[3])) + ((v1[0] * v1[0] + v1[1] * v1[1]) + (v1[2] * v1[2] + v1[3] * v1[3]));
                    }
                    if (ACT == 2) {
#pragma unroll
                        for (int e = 0; e < 4; ++e) { const float a = __builtin_fmaxf(v0[e], 0.f), b = __builtin_fmaxf(v1[e], 0.f); v0[e] = a * a; v1[e] = b * b; }
                    }
                    u32x4 w; w.x = cvt_pk_bf16(v0[0], v0[1]); w.y = cvt_pk_bf16(v0[2], v0[3]); w.z = cvt_pk_bf16(v1[0], v1[1]); w.w = cvt_pk_bf16(v1[2], v1[3]);
                    *(u32x4*)(rowp + bj * HALF) = w; }
                if (ACT == 1) { if (do_stats) {
                    s1 = fq_sum(s1); s2 = fq_sum(s2);
                    if (fq == 0) *(f32x2*)(stats + ((size_t)row * 32 + (u.pn - stats_pn0) * 4 + wc) * 2) = (f32x2){s1, s2}; } }
            }
    }
};
struct EpiQKVG {
    static constexpr bool PERM = true, AFTER_DRAIN = false, HAS_INIT = false, HAS_PRE = true;
    bf16_t* O; int ldc; size_t split_stride; const float* xs; const float* qg; const float* kg; PG8_LAS float* xl; float qscale; const PG8_LAS float* rsl; int rs_pm; size_t batch_extra;
    f32x4 rs_raw; PG8_LAS float* rsl_w;
    __device__ __forceinline__ void pre(int tid) const { if (tid < BM) rsl_w[tid] = 1.0f / sqrtf(((rs_raw[0] + rs_raw[1]) + (rs_raw[2] + rs_raw[3])) * (1.0f / 1024.0f) + 1e-6f); }

    __device__ __forceinline__ void operator()(const f32x4 (&acc)[2][2][4][2], const Unit& u, int wr, int wc, int fr, int fq) const {
        const int row0 = u.pm * BM + wr * 64 + fr; const int t = u.pn >> 2; bf16_t* base = O + (size_t)t * split_stride + (size_t)(u.pm >> 3) * batch_extra;
        const int col0 = (u.pn & 3) * BM + wc * 32 + 8 * fq;
        float rsv[2][4];
        if (u.pm == rs_pm) {
#pragma unroll
          for (int ai = 0; ai < 2; ++ai)
#pragma unroll
            for (int m = 0; m < 4; ++m) rsv[ai][m] = rsl[wr * 64 + fr + ai * HALF + m * 16];
        } else
#pragma unroll
        for (int ai = 0; ai < 2; ++ai) { f32x4 xq[4];
#pragma unroll
            for (int m = 0; m < 4; ++m) xq[m] = *(const f32x4*)(xs + (size_t)(row0 + ai * HALF + m * 16) * 4);
#pragma unroll
            for (int m = 0; m < 4; ++m) rsv[ai][m] = 1.0f / sqrtf(((xq[m][0] + xq[m][1]) + (xq[m][2] + xq[m][3])) * (1.0f / 1024.0f) + 1e-6f);
            asm volatile("" ::: "memory"); }
        if (t < 2) {
#pragma unroll
            for (int ai = 0; ai < 2; ++ai)
#pragma unroll
                for (int m = 0; m < 4; ++m)
#pragma unroll
                    for (int bj = 0; bj < 2; ++bj) { const f32x4 v0 = acc[ai][bj][m][0], v1 = acc[ai][bj][m][1];
                        float ss = ((v0[0] * v0[0] + v0[1] * v0[1]) + (v0[2] * v0[2] + v0[3] * v0[3])) + ((v1[0] * v1[0] + v1[1] * v1[1]) + (v1[2] * v1[2] + v1[3] * v1[3]));
                        ss = fq_sum(ss); ss *= rsv[ai][m] * rsv[ai][m];
                        if (fq == 0) xl[((ai * HALF + wr * 64 + m * 16 + fr) * 2 + bj) * 4 + wc] = ss; asm volatile("" ::: "memory"); }
            asm volatile("s_waitcnt lgkmcnt(0)" ::: "memory"); __builtin_amdgcn_s_barrier(); asm volatile("" ::: "memory");
            const float* gp = (t == 0 ? qg : kg) + 32 * (wc & 1) + 8 * fq; const f32x4 g0 = *(const f32x4*)gp, g1 = *(const f32x4*)(gp + 4); const float sc = (t == 0) ? qscale : 1.0f;
#pragma unroll
            for (int ai = 0; ai < 2; ++ai)
#pragma unroll
                for (int m = 0; m < 4; ++m) { const int rl = ai * HALF + wr * 64 + m * 16 + fr; bf16_t* rowp = base + (size_t)(u.pm * BM + rl) * ldc + col0;
#pragma unroll
                    for (int bj = 0; bj < 2; ++bj) { const f32x2 pr = *(const PG8_LAS f32x2*)(xl + (rl * 2 + bj) * 4 + (wc & 2)); const float tot = pr[0] + pr[1];
                        const float hr = sc * rsv[ai][m] / sqrtf(tot * (1.0f / 64.0f) + 1e-6f);
                        const f32x4 v0 = acc[ai][bj][m][0] * hr * g0, v1 = acc[ai][bj][m][1] * hr * g1;
                        u32x4 w; w.x = cvt_pk_bf16(v0[0], v0[1]); w.y = cvt_pk_bf16(v0[2], v0[3]); w.z = cvt_pk_bf16(v1[0], v1[1]); w.w = cvt_pk_bf16(v1[2], v1[3]);
                        *(u32x4*)(rowp + bj * HALF) = w; }
                    asm volatile("" ::: "memory"); }
        } else {
#pragma unroll
            for (int ai = 0; ai < 2; ++ai)
#pragma unroll
                for (int m = 0; m < 4; ++m) { bf16_t* rowp = base + (size_t)(row0 + ai * HALF + m * 16) * ldc + col0; const float rs = rsv[ai][m];
#pragma unroll
                    for (int bj = 0; bj < 2; ++bj) { const f32x4 v0 = acc[ai][bj][m][0] * rs, v1 = acc[ai][bj][m][1] * rs;
                        u32x4 w; w.x = cvt_pk_bf16(v0[0], v0[1]); w.y = cvt_pk_bf16(v0[2], v0[3]); w.z = cvt_pk_bf16(v1[0], v1[1]); w.w = cvt_pk_bf16(v1[2], v1[3]);
                        *(u32x4*)(rowp + bj * HALF) = w; } }
        }
    }
};
struct EpiRes {
    static constexpr bool PERM = true, AFTER_DRAIN = false, HAS_INIT = true, HAS_PRE = false;
    const float* base32; float* out32; bf16_t* xn; float* xs; int ldc; PG8_LAS float* xl;
    __device__ __forceinline__ void init_slow(f32x4 (&acc)[2][2][4][2], const Unit& u, int wr, int wc, int fr, int fq) const {
        const int col0 = u.pn * BM + wc * 32 + 8 * fq;
#pragma unroll
        for (int ai = 0; ai < 2; ++ai)
#pragma unroll
            for (int m = 0; m < 4; ++m) { const size_t off = (size_t)(u.pm * BM + ai * HALF + wr * 64 + m * 16 + fr) * ldc + col0;
#pragma unroll
                for (int bj = 0; bj < 2; ++bj) { const size_t p = off + bj * HALF;
                    if (base32) { acc[ai][bj][m][0] = *(const f32x4*)(base32 + p); acc[ai][bj][m][1] = *(const f32x4*)(base32 + p + 4); }
                    else { const u32x4 r = *(const u32x4*)(xn + p); acc[ai][bj][m][0] = (f32x4){__uint_as_float(r.x << 16), __uint_as_float(r.x & 0xffff0000u), __uint_as_float(r.y << 16), __uint_as_float(r.y & 0xffff0000u)};
                        acc[ai][bj][m][1] = (f32x4){__uint_as_float(r.z << 16), __uint_as_float(r.z & 0xffff0000u), __uint_as_float(r.w << 16), __uint_as_float(r.w & 0xffff0000u)}; }
                    asm volatile("" : "+v"(acc[ai][bj][m][0]), "+v"(acc[ai][bj][m][1]) :: "memory"); } }
    }
    __device__ __forceinline__ void init(f32x4 (&acc)[2][2][4][2], const Unit& u, int wr, int wc, int fr, int fq) const {
        const int col0 = u.pn * BM + wc * 32 + 8 * fq;
#pragma unroll
        for (int ai = 0; ai < 2; ++ai)
#pragma unroll
            for (int m = 0; m < 4; ++m) { const size_t off = (size_t)(u.pm * BM + ai * HALF + wr * 64 + m * 16 + fr) * ldc + col0;
#pragma unroll
                for (int bj = 0; bj < 2; ++bj) { const size_t p = off + bj * HALF;
                    if (base32) { acc[ai][bj][m][0] = *(const f32x4*)(base32 + p); acc[ai][bj][m][1] = *(const f32x4*)(base32 + p + 4); }
                    else { const u32x4 r = *(const u32x4*)(xn + p); acc[ai][bj][m][0] = (f32x4){__uint_as_float(r.x << 16), __uint_as_float(r.x & 0xffff0000u), __uint_as_float(r.y << 16), __uint_as_float(r.y & 0xffff0000u)};
                        acc[ai][bj][m][1] = (f32x4){__uint_as_float(r.z << 16), __uint_as_float(r.z & 0xffff0000u), __uint_as_float(r.w << 16), __uint_as_float(r.w & 0xffff0000u)}; } } }
#pragma unroll
        for (int ai = 0; ai < 2; ++ai)
#pragma unroll
            for (int bj = 0; bj < 2; ++bj)
#pragma unroll
                for (int m = 0; m < 4; ++m) asm volatile("" : "+v"(acc[ai][bj][m][0]), "+v"(acc[ai][bj][m][1]));
    }
    __device__ __forceinline__ void operator()(const f32x4 (&acc)[2][2][4][2], const Unit& u, int wr, int wc, int fr, int fq) const {
        const int col0 = u.pn * BM + wc * 32 + 8 * fq;
#pragma unroll
        for (int ai = 0; ai < 2; ++ai)
#pragma unroll
            for (int m = 0; m < 4; ++m) { const int row = u.pm * BM + ai * HALF + wr * 64 + m * 16 + fr; const size_t off = (size_t)row * ldc + col0; float ss = 0.f;
#pragma unroll
                for (int bj = 0; bj < 2; ++bj) { const size_t p = off + bj * HALF; const f32x4 v0 = acc[ai][bj][m][0], v1 = acc[ai][bj][m][1];
                    ss += ((v0[0] * v0[0] + v0[1] * v0[1]) + (v0[2] * v0[2] + v0[3] * v0[3])) + ((v1[0] * v1[0] + v1[1] * v1[1]) + (v1[2] * v1[2] + v1[3] * v1[3]));
                    if (out32) { *(f32x4*)(out32 + p) = v0; *(f32x4*)(out32 + p + 4) = v1; }
                    if (!out32) { u32x4 w; w.x = cvt_pk_bf16(v0[0], v0[1]); w.y = cvt_pk_bf16(v0[2], v0[3]); w.z = cvt_pk_bf16(v1[0], v1[1]); w.w = cvt_pk_bf16(v1[2], v1[3]);
                    *(u32x4*)(xn + p) = w; } }
                ss = fq_sum(ss);
                if (fq == 0) xl[(ai * HALF + wr * 64 + m * 16 + fr) * 4 + wc] = ss;
                asm volatile("" ::: "memory"); }
        asm volatile("s_waitcnt lgkmcnt(0)" ::: "memory"); __builtin_amdgcn_s_barrier(); asm volatile("" ::: "memory");
        { const int t = (wr * 4 + wc) * 64 + fq * 16 + fr;
          if (t < BM) { const f32x4 q = *(const PG8_LAS f32x4*)(xl + t * 4); xs[(size_t)(u.pm * BM + t) * 4 + u.pn] = (q[0] + q[1]) + (q[2] + q[3]); } }
    }
};

template <class Epi, class Sched, bool ALIGN_EPI = false, bool SP2 = false>
__device__ __forceinline__ void gemm_phase(PG8_LAS unsigned char* lds, const Gemm g, const Sched& S, const Epi& E, const int tid_in) {
    const int tid = tid_in, wid = __builtin_amdgcn_readfirstlane(tid >> 6), lane = tid & 63, wr = wid >> 2, wc = wid & 3, fr = lane & 15, fq = lane >> 4;
    const int K = g.K, nt = K / BK;
    unsigned voffA[2], voffB[2];
#pragma unroll
    for (int i = 0; i < 2; ++i) { int R, C; stage_rc(tid * 16 + i * 8192, R, C); const int Rb = Epi::PERM ? ((R & ~31) + perm32(R & 31)) : R;
        voffA[i] = (unsigned)(R * g.lda + C) * 2u; voffB[i] = (unsigned)(Rb * K + C) * 2u; }
    const size_t kstep = (size_t)(BK * 2);
    const size_t hstepB = (size_t)HALF * K * 2, hstepA = (size_t)HALF * g.lda * 2;
    const size_t tstepB = 2 * hstepB, tstepA = 2 * hstepA;
    const unsigned ldsw = (unsigned)wid * 1024u;
    const int aoff = lds_byte(wr * 64 + fr, fq * 8), boff = lds_byte(wc * 32 + fr, fq * 8);
#define PG8_SA(b, h) (((b) * 2 + (h)) * HTB)
#define PG8_SB(b, h) ((4 + (b) * 2 + (h)) * HTB)
#define PG8_STAGE(bufoff, gbase, voff) do { _Pragma("unroll") for (int _i = 0; _i < 2; ++_i) \
        __builtin_amdgcn_global_load_lds((const unsigned*)((const char*)(gbase) + (voff)[_i]), (PG8_LAS unsigned*)(lds + (bufoff) + ldsw + _i * 8192), 16, 0, 0); } while (0)
#define PG8_LDA(dst, b, h) do { _Pragma("unroll") for (int m = 0; m < 4; ++m) _Pragma("unroll") for (int k = 0; k < 2; ++k) dst[m][k] = *(const PG8_LAS bf16x8*)(lds + PG8_SA(b, h) + aoff + m * 2048 + k * 1024); } while (0)
#define PG8_LDB(dst, b, h) do { _Pragma("unroll") for (int n = 0; n < 2; ++n) _Pragma("unroll") for (int k = 0; k < 2; ++k) dst[n][k] = *(const PG8_LAS bf16x8*)(lds + PG8_SB(b, h) + boff + n * 2048 + k * 1024); } while (0)
#define PG8_MMA(ai, bj, At, Bt) do { __builtin_amdgcn_s_setprio(1); _Pragma("unroll") for (int m = 0; m < 4; ++m) _Pragma("unroll") for (int n = 0; n < 2; ++n) _Pragma("unroll") for (int k = 0; k < 2; ++k) \
        acc[ai][bj][m][n] = __builtin_amdgcn_mfma_f32_16x16x32_bf16(Bt[n][k], At[m][k], acc[ai][bj][m][n], 0, 0, 0); __builtin_amdgcn_s_setprio(0); } while (0)
#define PG8_WAIT_V(n) asm volatile("s_waitcnt vmcnt(" #n ")" ::: "memory")
#define PG8_WAIT_L(n) asm volatile("s_waitcnt lgkmcnt(" #n ")" ::: "memory")
#define PG8_BAR __builtin_amdgcn_s_barrier()
#define PG8_SCHED __builtin_amdgcn_sched_barrier(0)
    Unit cur, nxt; int ui = 0;
    if (!S.next(0, cur)) return;
    f32x4 acc[2][2][4][2];
    if constexpr (Epi::HAS_INIT) { E.init(acc, cur, wr, wc, fr, fq); }
    else {
#pragma unroll
    for (int a = 0; a < 2; ++a)
#pragma unroll
        for (int b = 0; b < 2; ++b)
#pragma unroll
            for (int m = 0; m < 4; ++m)
#pragma unroll
                for (int n = 0; n < 2; ++n) acc[a][b][m][n] = (f32x4){0.f, 0.f, 0.f, 0.f};
    }
    bf16x8 At[4][2], B0[2][2], B1[2][2];
    const char* cA = (const char*)g.A + (size_t)cur.pm * tstepA + (size_t)(cur.pm >> 3) * g.abx; const char* cB = (const char*)g.Bt + (size_t)cur.pn * tstepB;
    S.a_ready(cur);
    if constexpr (SP2) {
        PG8_STAGE(PG8_SB(0, 0), cB, voffB); PG8_STAGE(PG8_SB(0, 1), cB + hstepB, voffB); PG8_STAGE(PG8_SA(0, 0), cA, voffA); PG8_STAGE(PG8_SA(0, 1), cA + hstepA, voffA);
        if (wr == 1) PG8_BAR;
        PG8_WAIT_V(2); PG8_BAR;
        PG8_STAGE(PG8_SB(1, 0), cB + kstep, voffB); PG8_STAGE(PG8_SA(1, 0), cA + kstep, voffA); PG8_STAGE(PG8_SB(1, 1), cB + hstepB + kstep, voffB);
        PG8_WAIT_V(6); PG8_BAR;
    } else {
        PG8_STAGE(PG8_SB(0, 0), cB, voffB); PG8_STAGE(PG8_SA(0, 0), cA, voffA); PG8_STAGE(PG8_SB(0, 1), cB + hstepB, voffB); PG8_STAGE(PG8_SA(0, 1), cA + hstepA, voffA);
        if (wr == 1) PG8_BAR;
        PG8_WAIT_V(4); PG8_BAR;
        PG8_STAGE(PG8_SB(1, 0), cB + kstep, voffB); PG8_STAGE(PG8_SA(1, 0), cA + kstep, voffA); PG8_STAGE(PG8_SB(1, 1), cB + hstepB + kstep, voffB);
        PG8_WAIT_V(6); PG8_BAR;
    }
    if constexpr (Epi::HAS_PRE) E.pre(tid);
    for (;;) {
        const bool has_next = S.next(ui + 1, nxt);
        const char* nA = has_next ? (const char*)g.A + (size_t)nxt.pm * tstepA + (size_t)(nxt.pm >> 3) * g.abx : cA; const char* nB = has_next ? (const char*)g.Bt + (size_t)nxt.pn * tstepB : cB;
        for (int t = 0; t < nt; t += 2) {
            const bool last = (t == nt - 2);
            const char* a1 = cA + (size_t)(t + 1) * kstep;
            const char* a2 = last ? nA : cA + (size_t)(t + 2) * kstep; const char* b2 = last ? nB : cB + (size_t)(t + 2) * kstep;
            const char* a3 = a2 + kstep; const char* b3 = b2 + kstep;
            if (last && has_next) S.a_ready(nxt);
            if constexpr (SP2) {
            PG8_LDB(B0, 0, 0); PG8_LDB(B1, 0, 1); PG8_SCHED; PG8_LDA(At, 0, 0); PG8_STAGE(PG8_SA(1, 1), a1 + hstepA, voffA);
            PG8_WAIT_V(8); PG8_WAIT_L(0); PG8_BAR; PG8_MMA(0, 0, At, B0); PG8_MMA(0, 1, At, B1); PG8_BAR; PG8_SCHED;
            PG8_LDA(At, 0, 1); PG8_STAGE(PG8_SB(0, 0), b2, voffB); PG8_STAGE(PG8_SB(0, 1), b2 + hstepB, voffB); PG8_STAGE(PG8_SA(0, 0), a2, voffA);
            PG8_WAIT_V(8); PG8_WAIT_L(0); PG8_BAR; PG8_MMA(1, 0, At, B0); PG8_MMA(1, 1, At, B1); PG8_BAR; PG8_SCHED;
            PG8_LDB(B0, 1, 0); PG8_LDB(B1, 1, 1); PG8_SCHED; PG8_LDA(At, 1, 0); PG8_STAGE(PG8_SA(0, 1), a2 + hstepA, voffA);
            PG8_WAIT_V(8); PG8_WAIT_L(0); PG8_BAR; PG8_MMA(0, 0, At, B0); PG8_MMA(0, 1, At, B1); PG8_BAR; PG8_SCHED;
            PG8_LDA(At, 1, 1); PG8_STAGE(PG8_SB(1, 0), b3, voffB); PG8_STAGE(PG8_SB(1, 1), b3 + hstepB, voffB); PG8_STAGE(PG8_SA(1, 0), a3, voffA);
            PG8_WAIT_V(8); PG8_WAIT_L(0); PG8_BAR; PG8_MMA(1, 0, At, B0); PG8_MMA(1, 1, At, B1); PG8_BAR; PG8_SCHED;
            } else {
            PG8_LDB(B0, 0, 0); PG8_SCHED; PG8_LDA(At, 0, 0); PG8_STAGE(PG8_SA(1, 1), a1 + hstepA, voffA);
            PG8_WAIT_L(8); PG8_BAR; PG8_WAIT_L(0); PG8_MMA(0, 0, At, B0); PG8_BAR; PG8_SCHED;
            PG8_LDB(B1, 0, 1); PG8_STAGE(PG8_SB(0, 0), b2, voffB);
            PG8_BAR; PG8_WAIT_L(0); PG8_MMA(0, 1, At, B1); PG8_BAR;
            PG8_LDA(At, 0, 1); PG8_STAGE(PG8_SA(0, 0), a2, voffA);
            PG8_BAR; PG8_WAIT_L(0); PG8_MMA(1, 0, At, B0); PG8_BAR; PG8_SCHED;
            PG8_STAGE(PG8_SB(0, 1), b2 + hstepB, voffB);
            PG8_WAIT_V(6); PG8_BAR; PG8_MMA(1, 1, At, B1); PG8_BAR;
            PG8_LDB(B0, 1, 0); PG8_SCHED; PG8_LDA(At, 1, 0); PG8_STAGE(PG8_SA(0, 1), a2 + hstepA, voffA);
            PG8_WAIT_L(8); PG8_BAR; PG8_WAIT_L(0); PG8_MMA(0, 0, At, B0); PG8_BAR; PG8_SCHED;
            PG8_LDB(B1, 1, 1); PG8_STAGE(PG8_SB(1, 0), b3, voffB);
            PG8_BAR; PG8_WAIT_L(0); PG8_MMA(0, 1, At, B1); PG8_BAR;
            PG8_LDA(At, 1, 1); PG8_STAGE(PG8_SA(1, 0), a3, voffA);
            PG8_BAR; PG8_WAIT_L(0); PG8_MMA(1, 0, At, B0); PG8_BAR; PG8_SCHED;
            PG8_STAGE(PG8_SB(1, 1), b3 + hstepB, voffB);
            PG8_WAIT_V(6); PG8_BAR; PG8_MMA(1, 1, At, B1); PG8_BAR;
            }
        }
        if constexpr (ALIGN_EPI) { if (wr == 0) PG8_BAR; }
        if constexpr (!Epi::AFTER_DRAIN) { E(acc, cur, wr, wc, fr, fq); S.done(cur); }
        if (!has_next) break;
        if constexpr (Epi::HAS_INIT) { E.init_slow(acc, nxt, wr, wc, fr, fq); } else
#pragma unroll
        for (int a = 0; a < 2; ++a)
#pragma unroll
            for (int b = 0; b < 2; ++b)
#pragma unroll
                for (int m = 0; m < 4; ++m)
#pragma unroll
                    for (int n = 0; n < 2; ++n) acc[a][b][m][n] = (f32x4){0.f, 0.f, 0.f, 0.f};
        cur = nxt; cA = nA; cB = nB; ++ui;
        if constexpr (ALIGN_EPI) { if (wr == 1) PG8_BAR; }
    }
    PG8_WAIT_V(0);
    if constexpr (!ALIGN_EPI) { if (wr == 0) PG8_BAR; }
    PG8_BAR;
    if constexpr (Epi::AFTER_DRAIN) { E.fused(acc, cur, wr, wc, fr, fq, lds, wid, lane); S.done(cur); }
#undef PG8_SA
#undef PG8_SB
#undef PG8_STAGE
#undef PG8_LDA
#undef PG8_LDB
#undef PG8_MMA
#undef PG8_WAIT_V
#undef PG8_WAIT_L
#undef PG8_BAR
#undef PG8_SCHED
}
}
#include <hip/hip_bf16.h>
#include <cmath>
namespace attn_body {
using bf16=__hip_bfloat16;
using bf16x8=__attribute__((ext_vector_type(8)))short;
using s16x4=__attribute__((ext_vector_type(4)))short;
using f32x16=__attribute__((ext_vector_type(16)))float;
using u32x4=__attribute__((ext_vector_type(4)))unsigned;
constexpr int BATCH=8,NHEAD=16,SEQ=2048,D=64,DM=NHEAD*D;
constexpr int NW=8,QBLK=32,QB=QBLK*NW,KVBLK=64,NQB=SEQ/QB;
constexpr int ATTN_PITCH=DM, ATTN_UNIT_ROWS=QB;
__device__ __forceinline__ int crow(int r,int hi){return (r&3)+8*(r>>2)+4*hi;}
#define SBAR() __builtin_amdgcn_sched_barrier(0)
__device__ __forceinline__ void cmask(f32x16&p0,f32x16&p1,int jb,int qrel,int hi){
  const float NEG=-INFINITY; int kb=64*jb+4*hi;
  #pragma unroll
  for(int r=0;r<16;++r){int kv=kb+(r&3)+8*(r>>2); if(kv>qrel)p0[r]=NEG; if(kv+32>qrel)p1[r]=NEG;}
}

constexpr int NSLOT=3, SLOTB=8192;
constexpr int LDS_K=0, LDS_V=NSLOT*SLOTB, LDS_WS=2*NSLOT*SLOTB, LDS_OST=LDS_WS+NW*64*4, LDS_KB3=LDS_OST+NW*4096, LDS_BYTES=LDS_KB3+SEQ*8;
constexpr float C2=0.125f*1.4426950408889634f;
__device__ __forceinline__ void glds16(const void*gsrc,unsigned lds_dst){unsigned keep;
  asm volatile("s_mov_b32 %0, m0\n\ts_mov_b32 m0, %2\n\ts_nop 0\n\tglobal_load_lds_dwordx4 %1, off\n\ts_mov_b32 m0, %0":"=&s"(keep):"v"(gsrc),"s"(lds_dst):"memory");}
__device__ __forceinline__ float max3f(float a,float b,float c){float r;asm("v_max3_f32 %0, %1, %2, %3":"=v"(r):"v"(a),"v"(b),"v"(c));return r;}
__device__ __forceinline__ float max2f(float a,float b){float r;asm("v_max_f32_e32 %0, %1, %2":"=v"(r):"v"(a),"v"(b));return r;}
__device__ __forceinline__ float fadd_s(float a,float b){float r;asm("v_add_f32_e32 %0, %1, %2":"=v"(r):"v"(a),"v"(b));return r;}
__device__ __forceinline__ float fsub_s(float a,float b){float r;asm("v_sub_f32_e32 %0, %1, %2":"=v"(r):"v"(a),"v"(b));return r;}
typedef unsigned u32x2_t __attribute__((ext_vector_type(2)));
typedef float f32x2_t __attribute__((ext_vector_type(2))); typedef __bf16 bf16x2_t __attribute__((ext_vector_type(2)));
__device__ __forceinline__ unsigned cvtpk_s(float lo,float hi){f32x2_t v={lo,hi};bf16x2_t b=__builtin_convertvector(v,bf16x2_t);return __builtin_bit_cast(unsigned,b);}
#define WAIT_BAR(N) asm volatile("s_waitcnt vmcnt(" #N ") lgkmcnt(0)\n\ts_barrier":::"memory")

__device__ __forceinline__ void qkt(f32x16&p0,f32x16&p1,const char*Kslot,const bf16x8*qr,const f32x16&negm,int r32,int hi,bf16x8 kbA,bf16x8 kbB,bf16x8 ones){
  p0=__builtin_amdgcn_mfma_f32_32x32x16_bf16(kbA,ones,negm,0,0,0);p1=__builtin_amdgcn_mfma_f32_32x32x16_bf16(kbB,ones,negm,0,0,0);
  const char*kb=Kslot+hi*1024+r32*16;
  #pragma unroll
  for(int d0=0;d0<4;++d0){
    const bf16x8 b0=*reinterpret_cast<const bf16x8*>(kb+d0*2048);
    const bf16x8 b1=*reinterpret_cast<const bf16x8*>(kb+d0*2048+512);
    {p0=__builtin_amdgcn_mfma_f32_32x32x16_bf16(b0,qr[d0],p0,0,0,0);p1=__builtin_amdgcn_mfma_f32_32x32x16_bf16(b1,qr[d0],p1,0,0,0);}}
}
typedef __attribute__((address_space(3))) const char* lds_cptr;
typedef short v4i16_t __attribute__((ext_vector_type(4)));
__device__ __forceinline__ void kload8(bf16x8*kf,lds_cptr kp){
  kf[0]=*(const __attribute__((address_space(3))) bf16x8*)(kp);      kf[1]=*(const __attribute__((address_space(3))) bf16x8*)(kp+512);
  kf[2]=*(const __attribute__((address_space(3))) bf16x8*)(kp+2048); kf[3]=*(const __attribute__((address_space(3))) bf16x8*)(kp+2560);
  kf[4]=*(const __attribute__((address_space(3))) bf16x8*)(kp+4096); kf[5]=*(const __attribute__((address_space(3))) bf16x8*)(kp+4608);
  kf[6]=*(const __attribute__((address_space(3))) bf16x8*)(kp+6144); kf[7]=*(const __attribute__((address_space(3))) bf16x8*)(kp+6656);
}
__device__ __forceinline__ void kload2(bf16x8*kf,lds_cptr kp,int j){ kf[2*j]=*(const __attribute__((address_space(3))) bf16x8*)(kp+j*2048); kf[2*j+1]=*(const __attribute__((address_space(3))) bf16x8*)(kp+j*2048+512); }
__device__ __forceinline__ s16x4 vtr(lds_cptr p){ return __builtin_bit_cast(s16x4,__builtin_amdgcn_ds_read_tr16_b64_v4i16((__attribute__((address_space(3))) v4i16_t*)p)); }
__device__ __forceinline__ float rowmax(const f32x16&p0,const f32x16&p1){
  float a=max3f(p0[0],p0[1],p1[0]),b=max3f(p0[2],p0[3],p1[1]);a=max3f(a,p1[2],p1[3]);
  #pragma unroll
  for(int r=4;r<16;r+=4){a=max3f(a,p0[r],p0[r+1]);b=max3f(b,p0[r+2],p0[r+3]);a=max3f(a,p1[r],p1[r+1]);b=max3f(b,p1[r+2],p1[r+3]);}
  const float m=max2f(a,b);
  auto rr=__builtin_amdgcn_permlane32_swap(__float_as_uint(m),__float_as_uint(m),false,false);
  return max2f(__uint_as_float(rr[0]),__uint_as_float(rr[1]));
}
__device__ __forceinline__ void pv(f32x16*o,int vb,bf16x8 pa0,bf16x8 pa1,bf16x8 pa2,bf16x8 pa3){
  #pragma unroll
  for(int d0=0;d0<2;++d0){s16x4 lo[4],hi[4];
    #pragma unroll
    for(int ks=0;ks<4;++ks){
      asm volatile("ds_read_b64_tr_b16 %0,%1 offset:%c2":"=&v"(lo[ks]):"v"(vb),"i"(d0*4096+ks*1024):"memory");
      asm volatile("ds_read_b64_tr_b16 %0,%1 offset:%c2":"=&v"(hi[ks]):"v"(vb),"i"(d0*4096+ks*1024+512):"memory");}
    asm volatile("s_waitcnt lgkmcnt(0)":::"memory");SBAR();
    #define PK(k) (bf16x8){lo[k][0],lo[k][1],lo[k][2],lo[k][3],hi[k][0],hi[k][1],hi[k][2],hi[k][3]}
    o[d0]=__builtin_amdgcn_mfma_f32_32x32x16_bf16(pa0,PK(0),o[d0],0,0,0);
    o[d0]=__builtin_amdgcn_mfma_f32_32x32x16_bf16(pa1,PK(1),o[d0],0,0,0);
    o[d0]=__builtin_amdgcn_mfma_f32_32x32x16_bf16(pa2,PK(2),o[d0],0,0,0);
    o[d0]=__builtin_amdgcn_mfma_f32_32x32x16_bf16(pa3,PK(3),o[d0],0,0,0);
    #undef PK
  }
}

#ifndef ATTN_STORE16
#define ATTN_STORE16(p,v) (*(u32x4*)(p)=(v))
#endif
template<int THRL> __device__ __forceinline__ void attn_unit(int b,int h,int qb,const bf16*Q,const bf16*__restrict__ K,const bf16*__restrict__ V,bf16*O,const bf16*__restrict__ Gt,const float*__restrict__ LOGF,const float qkbound,char*shm,const int tid_in){
  const int tid=tid_in,lane=tid&63,r32=lane&31,hi=lane>>5; const int wid=__builtin_amdgcn_readfirstlane(tid>>6);
  const long rowbase=(long)b*SEQ; const int q0=qb*QB;
  const bf16*Qw=Q+(rowbase+q0+wid*QBLK)*DM+h*D;
  const bf16*Kh=K+rowbase*DM+h*D,*Vh=V+rowbase*DM+h*D;
  const unsigned lds0=(unsigned)(uintptr_t)shm;
  float*wsf=(float*)(shm+LDS_WS)+wid*64;
  const bf16*ksrc0_=Kh+(long)lane*DM+wid*8;
  const bf16*vsrc0_=Vh+(long)(16*(wid&3)+(lane>>2))*DM+(wid>>2)*32+(lane&3)*8;
  const unsigned kdst=lds0+LDS_K+wid*1024, vdst=lds0+LDS_V+wid*1024;
  #define DMA_K(t,slot) glds16(ksrc+(long)(t)*KVBLK*DM,(unsigned)__builtin_amdgcn_readfirstlane(kdst+(slot)))
  #define DMA_V(t,slot) glds16(vsrc+(long)(t)*KVBLK*DM,(unsigned)__builtin_amdgcn_readfirstlane(vdst+(slot)))
  const int vb0=(int)(lds0+LDS_V)+((lane>>4)&1)*32+(lane&3)*8+(4*hi+((lane&15)>>2))*64;
  const char*Kbase=shm+LDS_K; bf16x8 kf[8];
  const lds_cptr shm3=(lds_cptr)shm; const lds_cptr kp0=shm3+LDS_K+hi*1024+r32*16; const lds_cptr vp0=shm3+LDS_V+((lane>>4)&1)*32+(lane&3)*8+(4*hi+((lane&15)>>2))*64;
  const int NT0_=(q0+QB)/KVBLK;
  int t0_=0;
  {
    typedef float f32x4_a __attribute__((ext_vector_type(4))); const int nk=q0+QB; const f32x4_a x4=(4*tid<nk)?*(const f32x4_a*)(LOGF+(long)(b*NHEAD+h)*SEQ+4*tid):(f32x4_a){0.f,0.f,0.f,0.f};
    const float p0_=x4[0],p1_=p0_+x4[1],p2_=p1_+x4[2],p3_=p2_+x4[3]; float incl=p3_;
    #pragma unroll
    for(int off=1;off<64;off<<=1){const float t_=__uint_as_float((unsigned)__builtin_amdgcn_ds_bpermute(4*(lane-off),(int)__float_as_uint(incl))); if(lane>=off)incl+=t_;}
    __attribute__((address_space(3))) float*wsum=(__attribute__((address_space(3))) float*)(shm3+LDS_WS);
    if(lane==63)wsum[wid]=incl;
    asm volatile("s_waitcnt vmcnt(0) lgkmcnt(0)\n\ts_barrier":::"memory");
    float basec=incl-p3_;
    #pragma unroll
    for(int w_=0;w_<NW-1;++w_){const float ws_=wsum[w_]; if(w_<wid)basec+=ws_;}
    if(4*tid<nk){ const float L2E=1.4426950408889634f; unsigned long long e_[4]; const float pc_[4]={p0_,p1_,p2_,p3_};
      #pragma unroll
      for(int k_=0;k_<4;++k_){ const float v_=-(basec+pc_[k_])*L2E; const unsigned h_=__builtin_bit_cast(unsigned,__builtin_bit_cast(unsigned,v_));
        const unsigned hb_=(h_+0x7fffu+((h_>>16)&1u))>>16; const float r1_=v_-__uint_as_float(hb_<<16); const unsigned m1_=__builtin_bit_cast(unsigned,r1_); const unsigned mb_=(m1_+0x7fffu+((m1_>>16)&1u))>>16;
        const float r2_=r1_-__uint_as_float(mb_<<16); const unsigned l1_=__builtin_bit_cast(unsigned,r2_); const unsigned lb_=(l1_+0x7fffu+((l1_>>16)&1u))>>16;
        e_[k_]=(unsigned long long)hb_|((unsigned long long)mb_<<16)|((unsigned long long)lb_<<32)|(0x3F80ull<<48); }
      *(__attribute__((address_space(3))) u32x4*)(shm3+LDS_KB3+32*tid)=(u32x4){(unsigned)e_[0],(unsigned)(e_[0]>>32),(unsigned)e_[1],(unsigned)(e_[1]>>32)};
      *(__attribute__((address_space(3))) u32x4*)(shm3+LDS_KB3+32*tid+16)=(u32x4){(unsigned)e_[2],(unsigned)(e_[2]>>32),(unsigned)e_[3],(unsigned)(e_[3]>>32)};
      int tq_=tid>>4; asm volatile("":"+v"(tq_));
      if((tid&15)==15)wsum[16+tq_]=basec+p3_;
      if(4*tid==q0)wsum[48]=basec+p0_; }
    asm volatile("s_waitcnt lgkmcnt(0)\n\ts_barrier":::"memory");
    { const int j_=lane; const float cj_=wsum[16+(j_&31)], cq_=wsum[48];
      const bool sk_=(j_<NT0_-4)&&((cq_-cj_)*1.4426950408889634f+qkbound<-152.0f);
      const unsigned long long m_=__builtin_amdgcn_ballot_w64(sk_);
      t0_=(int)__builtin_amdgcn_readfirstlane((int)__builtin_ctzll(~m_))&~1; } }
  const int NT=NT0_-t0_; const bf16*ksrc=ksrc0_+(long)t0_*KVBLK*DM; const bf16*vsrc=vsrc0_+(long)t0_*KVBLK*DM;
  const lds_cptr kbl3=shm3+LDS_KB3+t0_*KVBLK*8;
  asm volatile("s_waitcnt vmcnt(0)":::"memory");
  bf16x8 ones;
  #define KBLOAD(t,FA,FB) bf16x8 FA,FB; { const lds_cptr kbp_=kbl3+((t)*KVBLK+r32)*8; \
      u32x2_t wa_=*(const __attribute__((address_space(3))) u32x2_t*)(kbp_), wb_=*(const __attribute__((address_space(3))) u32x2_t*)(kbp_+256); \
      if(hi){wa_=(u32x2_t){0u,0u};wb_=(u32x2_t){0u,0u};} \
      FA=__builtin_bit_cast(bf16x8,(u32x4){wa_[0],wa_[1],hi?0u:0x3F803F80u,0u}); FB=__builtin_bit_cast(bf16x8,(u32x4){wb_[0],wb_[1],hi?0u:0x3F803F80u,0u}); }
  DMA_K(0,0);DMA_V(0,0);DMA_K(1,SLOTB);
  bf16x8 qr[4];
  #pragma unroll
  for(int d0=0;d0<4;++d0)qr[d0]=*reinterpret_cast<const bf16x8*>(&Qw[(long)r32*DM+d0*16+hi*8]);
  float zero_; asm volatile("v_mov_b32 %0, 0":"=v"(zero_));
  float mhat=0.f,l_reg=0.f;f32x16 o[2];f32x16 negm;
  _Pragma("unroll") for(int r=0;r<16;++r){o[0][r]=zero_;o[1][r]=zero_;negm[r]=zero_;} asm volatile("":"+v"(negm));
  const int qrel=wid*QBLK+r32;
  #define CMASK(P0,P1,t) do{int jb_=(t)-(NT-4); if(jb_>=0)cmask(P0,P1,jb_,qrel,hi);}while(0)
  bool resc=false;
  #define START(P0,P1) do{ const float rm=rowmax(P0,P1); resc=false; \
    { const float dl=__builtin_fmaxf(rm,0.f); mhat=fadd_s(mhat,dl);     \
      _Pragma("unroll") for(int r=0;r<16;++r){P0[r]=fsub_s(P0[r],dl);P1[r]=fsub_s(P1[r],dl);} \
      _Pragma("unroll") for(int r=0;r<16;++r)negm[r]=-mhat; asm volatile("":"+v"(negm)); } \
    _Pragma("unroll") for(int r=0;r<16;++r)P0[r]=__builtin_amdgcn_exp2f(P0[r]); }while(0)
  #define RESC() do{ if(resc){ asm volatile("s_waitcnt lgkmcnt(0)":::"memory"); \
      _Pragma("unroll") for(int d_=0;d_<2;++d_) _Pragma("unroll") for(int r=0;r<16;++r)o[d_][r]*=wsf[crow(r,hi)]; } }while(0)
  f32x16 pA0,pA1,pB0,pB1;
  int sl_prev=0,sl_cur=0,sl_next=SLOTB;
  #define ROT() do{sl_prev=sl_cur;sl_cur=sl_next;sl_next=(sl_next==(NSLOT-1)*SLOTB)?0:sl_next+SLOTB;}while(0)
  DMA_K(2,2*SLOTB);
  WAIT_BAR(3);
  { const u32x2_t wq_=*(const __attribute__((address_space(3))) u32x2_t*)(shm3+LDS_KB3+(q0+wid*QBLK+r32)*8);
    ones=__builtin_bit_cast(bf16x8,(u32x4){hi?0u:0x3F803F80u, hi?0u:(0x3F80u|(((wq_[0]&0xffffu)^0x8000u)<<16)), hi?0u:(((wq_[0]>>16)^0x8000u)|(((wq_[1]&0xffffu)^0x8000u)<<16)), 0u}); }
  { KBLOAD(0,kbA0_,kbB0_); qkt(pA0,pA1,Kbase,qr,negm,r32,hi,kbA0_,kbB0_,ones); } asm volatile("s_nop 15\n\ts_nop 7":"+v"(pA0),"+v"(pA1));CMASK(pA0,pA1,0);
  START(pA0,pA1);
  _Pragma("unroll") for(int r=0;r<16;++r)pA1[r]=__builtin_amdgcn_exp2f(pA1[r]);
  WAIT_BAR(0);
  DMA_K(3,0);DMA_V(1,SLOTB);
  ROT();
  kload8(kf,kp0+sl_cur);
  WAIT_BAR(2);
  s16x4 vlo[8],vhi[8]; u32x4 pw0,pw1,pw2,pw3;
  #define PKW(P,B) cvtpk_s(P[B],P[B+1])
  #define PAF(k) __builtin_bit_cast(bf16x8,pw##k)
  #define VFR(i) (bf16x8){vlo[i][0],vlo[i][1],vlo[i][2],vlo[i][3],vhi[i][0],vhi[i][1],vhi[i][2],vhi[i][3]}
  #define PIN(x) asm volatile("":"+v"(x))
  #define MX3(a,b,c) __builtin_fmaxf(__builtin_fmaxf((a),(b)),(c))
  #define GAPA(MF,A0,A1,A2,A3,W0,W1,PW) do{ MF; sacc+=A0; sacc+=A1; sacc+=A2; sacc+=A3; PIN(sacc); W0; W1; PIN(PW); SBAR(); }while(0)
  #define EX(v) __builtin_amdgcn_exp2f(v)
  #define GAPB(MF,X,B) do{ MF; X[B]=EX(X[B]); X[B+1]=EX(X[B+1]); X[B+2]=EX(X[B+2]); X[B+3]=EX(X[B+3]); PIN(X); SBAR(); }while(0)
  #define VRD(i) do{ vlo[i]=vtr(vp_+(((i)>>2)*4096+((i)&3)*1024)); vhi[i]=vtr(vp_+(((i)>>2)*4096+((i)&3)*1024+512)); }while(0)
  #define KRD(G,j) do{ if(G){ kload2(kf,kp0+sl_next,j); SBAR(); } }while(0)
  #define STEP(C0,C1,P0,P1,t,GK,GV,GL) do{ SBAR(); \
    { KBLOAD(t,kbA_,kbB_); C0=__builtin_amdgcn_mfma_f32_32x32x16_bf16(kbA_,ones,negm,0,0,0); C1=__builtin_amdgcn_mfma_f32_32x32x16_bf16(kbB_,ones,negm,0,0,0); } SBAR(); \
    const lds_cptr vp_=vp0+sl_prev; \
    VRD(0); SBAR(); float sacc=(P0[0]+P0[1]); \
    GAPA(C0=__builtin_amdgcn_mfma_f32_32x32x16_bf16(kf[0],qr[0],C0,0,0,0), P0[2],P0[3],P0[4],P0[5],     pw0[0]=PKW(P0,0), pw0[1]=PKW(P0,2), pw0); \
    VRD(4); SBAR(); GAPA(C1=__builtin_amdgcn_mfma_f32_32x32x16_bf16(kf[1],qr[0],C1,0,0,0), P0[6],P0[7],P0[8],P0[9],     pw0[2]=PKW(P0,4), pw0[3]=PKW(P0,6), pw0); \
    VRD(1); SBAR(); GAPA(C0=__builtin_amdgcn_mfma_f32_32x32x16_bf16(kf[2],qr[1],C0,0,0,0),   P0[10],P0[11],P0[12],P0[13], pw1[0]=PKW(P0,8), pw1[1]=PKW(P0,10), pw1); \
    VRD(5); SBAR(); GAPA(C1=__builtin_amdgcn_mfma_f32_32x32x16_bf16(kf[3],qr[1],C1,0,0,0),   P0[14],P0[15],P1[0],P1[1],   pw1[2]=PKW(P0,12),pw1[3]=PKW(P0,14), pw1); \
    VRD(2); SBAR(); GAPA(C0=__builtin_amdgcn_mfma_f32_32x32x16_bf16(kf[4],qr[2],C0,0,0,0),   P1[2],P1[3],P1[4],P1[5],     pw2[0]=PKW(P1,0), pw2[1]=PKW(P1,2), pw2); \
    VRD(6); SBAR(); GAPA(C1=__builtin_amdgcn_mfma_f32_32x32x16_bf16(kf[5],qr[2],C1,0,0,0),   P1[6],P1[7],P1[8],P1[9],     pw2[2]=PKW(P1,4), pw2[3]=PKW(P1,6), pw2); \
    VRD(3); SBAR(); GAPA(C0=__builtin_amdgcn_mfma_f32_32x32x16_bf16(kf[6],qr[3],C0,0,0,0),   P1[10],P1[11],P1[12],P1[13], pw3[0]=PKW(P1,8), pw3[1]=PKW(P1,10), pw3); \
    VRD(7); SBAR(); GAPA(C1=__builtin_amdgcn_mfma_f32_32x32x16_bf16(kf[7],qr[3],C1,0,0,0),   P1[14],P1[15],0.f,0.f,       pw3[2]=PKW(P1,12),pw3[3]=PKW(P1,14), pw3); \
    l_reg+=sacc; \
    if(GK){DMA_K((t)+3,sl_cur);} if(GV){DMA_V((t)+1,sl_next);} \
    CMASK(C0,C1,t); \
    { float a=MX3(C0[0],C0[1],C1[0]),b=MX3(C0[2],C0[3],C1[1]); a=MX3(a,C1[2],C1[3]); \
      _Pragma("unroll") for(int r=4;r<16;r+=4){a=MX3(a,C0[r],C0[r+1]);b=MX3(b,C0[r+2],C0[r+3]);a=MX3(a,C1[r],C1[r+1]);b=MX3(b,C1[r+2],C1[r+3]);} \
      float rm=__builtin_fmaxf(a,b); { auto rr=__builtin_amdgcn_permlane32_swap(__float_as_uint(rm),__float_as_uint(rm),false,false); rm=__builtin_fmaxf(__uint_as_float(rr[0]),__uint_as_float(rr[1])); } \
      resc=false; \
      if(__builtin_expect(__any(rm>(float)THRL),0)){ const float dl=__builtin_fmaxf(rm,0.f); mhat+=dl; \
        _Pragma("unroll") for(int r=0;r<16;++r){C0[r]-=dl;C1[r]-=dl;} \
        _Pragma("unroll") for(int r=0;r<16;++r)negm[r]=-mhat; asm volatile("":"+v"(negm)); \
        const float f=__builtin_amdgcn_exp2f(-dl); l_reg*=f; if(hi==0)wsf[r32]=f; resc=true; } } \
    SBAR(); \
    GAPB(o[0]=__builtin_amdgcn_mfma_f32_32x32x16_bf16(PAF(0),VFR(0),o[0],0,0,0), C0,0); \
    GAPB(o[1]=__builtin_amdgcn_mfma_f32_32x32x16_bf16(PAF(0),VFR(4),o[1],0,0,0), C0,4); \
    KRD(GL,0); GAPB(o[0]=__builtin_amdgcn_mfma_f32_32x32x16_bf16(PAF(1),VFR(1),o[0],0,0,0), C0,8); \
    KRD(GL,1); GAPB(o[1]=__builtin_amdgcn_mfma_f32_32x32x16_bf16(PAF(1),VFR(5),o[1],0,0,0), C0,12); \
    KRD(GL,2); GAPB(o[0]=__builtin_amdgcn_mfma_f32_32x32x16_bf16(PAF(2),VFR(2),o[0],0,0,0), C1,0); \
    KRD(GL,3); GAPB(o[1]=__builtin_amdgcn_mfma_f32_32x32x16_bf16(PAF(2),VFR(6),o[1],0,0,0), C1,4); \
    GAPB(o[0]=__builtin_amdgcn_mfma_f32_32x32x16_bf16(PAF(3),VFR(3),o[0],0,0,0), C1,8); \
    GAPB(o[1]=__builtin_amdgcn_mfma_f32_32x32x16_bf16(PAF(3),VFR(7),o[1],0,0,0), C1,12); \
    }while(0)
  int t=1;
  #undef CMASK
  #define CMASK(P0,P1,t) do{}while(0)
  for(;t+5<NT;t+=2){
    STEP(pB0,pB1,pA0,pA1,t,true,true,true);     WAIT_BAR(2); RESC(); ROT();
    STEP(pA0,pA1,pB0,pB1,t+1,true,true,true);   WAIT_BAR(2); RESC(); ROT();
  }
  #undef CMASK
  #define CMASK(P0,P1,t) do{int jb_=(t)-(NT-4); if(jb_>=0)cmask(P0,P1,jb_,qrel,hi);}while(0)
  #define ENDW(tt) do{ if((tt)+3<NT){WAIT_BAR(2);} else if((tt)+2<NT){WAIT_BAR(1);} else {WAIT_BAR(0);} }while(0)
  for(;t+1<NT;t+=2){
    STEP(pB0,pB1,pA0,pA1,t,(t+3<NT),(t+1<NT),(t+1<NT));       ENDW(t);   RESC(); ROT();
    STEP(pA0,pA1,pB0,pB1,t+1,(t+4<NT),(t+2<NT),(t+2<NT));     ENDW(t+1); RESC(); ROT();
  }
  STEP(pB0,pB1,pA0,pA1,NT-1,false,false,false); RESC();
  { float sacc=pB0[0]+pB0[1]; _Pragma("unroll") for(int r=2;r<16;++r)sacc+=pB0[r]; _Pragma("unroll") for(int r=0;r<16;++r)sacc+=pB1[r]; l_reg+=sacc;
    pw0=(u32x4){PKW(pB0,0),PKW(pB0,2),PKW(pB0,4),PKW(pB0,6)};pw1=(u32x4){PKW(pB0,8),PKW(pB0,10),PKW(pB0,12),PKW(pB0,14)};pw2=(u32x4){PKW(pB1,0),PKW(pB1,2),PKW(pB1,4),PKW(pB1,6)};pw3=(u32x4){PKW(pB1,8),PKW(pB1,10),PKW(pB1,12),PKW(pB1,14)};
    SBAR(); pv(o,vb0+sl_cur,PAF(0),PAF(1),PAF(2),PAF(3)); }
  #undef PKW
  #undef PAF
  #undef VFR
  #undef PIN
  #undef MX3
  #undef GAPA
  #undef GAPB
  #undef EX
  #undef VRD
  #undef KRD
  #undef STEP
  #undef ENDW
  {auto rr=__builtin_amdgcn_permlane32_swap(__float_as_uint(l_reg),__float_as_uint(l_reg),false,false);l_reg=__uint_as_float(rr[0])+__uint_as_float(rr[1]);}
  if(hi==0)wsf[32+r32]=l_reg;asm volatile("s_waitcnt lgkmcnt(0)":::"memory");
  float rli[16];
  #pragma unroll
  for(int r=0;r<16;++r)rli[r]=__builtin_amdgcn_rcpf(wsf[32+crow(r,hi)]);
  bf16*Ow=O+(rowbase+q0+wid*QBLK)*DM+h*D; const bf16*Gw=Gt+(rowbase+q0+wid*QBLK)*DM+h*D;
  u32x4 gv[4];
  #pragma unroll
  for(int i=0;i<4;++i){const int row=i*8+(lane>>3),ch=lane&7; gv[i]=*(const u32x4*)(Gw+(long)row*DM+ch*8);}
  { bf16*stg=(bf16*)(shm+LDS_OST)+wid*2048;
    #pragma unroll
    for(int r=0;r<16;++r){const int orow=crow(r,hi);
      #pragma unroll
      for(int d0=0;d0<2;++d0)stg[orow*64+d0*32+r32]=__float2bfloat16(o[d0][r]*rli[r]);}
    asm volatile("s_waitcnt lgkmcnt(0)":::"memory");
    #pragma unroll
    for(int i=0;i<4;++i){const int row=i*8+(lane>>3),ch=lane&7; u32x4 v=*(const u32x4*)(stg+row*64+ch*8);
      #pragma unroll
      for(int w=0;w<4;++w){ const float olo=__uint_as_float(v[w]<<16), ohi=__uint_as_float(v[w]&0xffff0000u), glo=__uint_as_float(gv[i][w]<<16), ghi=__uint_as_float(gv[i][w]&0xffff0000u);
        const float slo=__builtin_amdgcn_rcpf(1.0f+__builtin_amdgcn_exp2f(-1.4426950408889634f*glo)), shi=__builtin_amdgcn_rcpf(1.0f+__builtin_amdgcn_exp2f(-1.4426950408889634f*ghi));
        v[w]=cvtpk_s(olo*slo,ohi*shi); }
      ATTN_STORE16(Ow+(long)row*DM+ch*8,v);} }
  asm volatile("s_waitcnt lgkmcnt(0)\n\ts_barrier":::"memory");
  #undef KBLOAD
  #undef DMA_K
  #undef DMA_V
  #undef CMASK
  #undef START
  #undef RESC
  #undef ROT
}
constexpr int ATTN_LDS_BYTES=LDS_BYTES;
struct AttnTensors { const bf16* Q; const bf16* K; const bf16* V; bf16* O; const bf16* G; const float* LOGF; float qkbound; };
struct AttnUnit { int bh; int qb; };
struct StaticOrder {
  int vcu, grid;
  __device__ __forceinline__ explicit StaticOrder(int grid_,int vcu_):vcu(vcu_),grid(grid_){}
  __device__ __forceinline__ bool next(int i,AttnUnit&u)const{ const int p=vcu+(i>>1)*grid; if(p>=BATCH*NHEAD*4)return false; const int q=(p&31)+32*(p>>8), s=(q<32)?(q&3):(3-(q&3)); u.bh=((p>>5)&7)*NHEAD+((q<32)?(q>>2):(NHEAD-1-((q-32)>>2)));     u.qb=(i&1)?(NQB-1-s):s; return true; }
  __device__ __forceinline__ void a_ready(const AttnUnit&)const{}
  __device__ __forceinline__ void done(const AttnUnit&)const{}
};
template<class Sched,int THRL=8> __device__ __forceinline__ void attn_phase(char*lds,const AttnTensors&T,const Sched&S,const int tid_in){
  AttnUnit u;
  for(int i=0;S.next(i,u);++i){ S.a_ready(u); { const long bo_=(long)(u.bh/NHEAD)*3*SEQ*DM;     attn_unit<THRL>(u.bh/NHEAD,u.bh%NHEAD,u.qb,T.Q+bo_,T.K+bo_,T.V+bo_,T.O+bo_,T.G+bo_,T.LOGF,T.qkbound,lds,tid_in); } S.done(u); }
}
#undef SBAR
#undef WAIT_BAR
}
namespace cg = cooperative_groups;
constexpr int NWAVES = 8;
constexpr int BATCH = 8, SEQ = 2048, D = 1024, M = BATCH * SEQ, FF = 4096, GE = 2048, FOXN = 4112, NPHASES = 21;
constexpr float RMS_EPS = 1e-6f, LN_EPS = 1e-5f;
constexpr size_t MiB = 1u << 20;
constexpr size_t WS_CTL = 0, WS_STATS = 1 * MiB  , WS_LOGF = 6 * MiB  ;
constexpr size_t WS_WF = 512 * 1024  , WS_XS = 5 * MiB  ;
constexpr size_t WS_WIN_G = 8 * MiB, WS_WOUT_G = 24 * MiB, WS_WIN_F = 32 * MiB, WS_WOUT_F = 48 * MiB, WS_W1 = 52 * MiB, WS_W2 = 84 * MiB;
constexpr size_t WS_XN = 116 * MiB, WS_BIG = 148 * MiB, WS_END = 276 * MiB;
constexpr int LDS_BYTES = 147456;
static_assert(attn_body::ATTN_LDS_BYTES <= 131072, "attention LDS");
#define LAS __attribute__((address_space(3)))
typedef unsigned short bf16;
typedef unsigned v4u __attribute__((ext_vector_type(4)));
typedef unsigned v2u __attribute__((ext_vector_type(2)));
typedef float f32x4 __attribute__((ext_vector_type(4)));
typedef short bf16x8 __attribute__((ext_vector_type(8)));
__device__ __forceinline__ unsigned f2bf(float f) { unsigned u = __builtin_bit_cast(unsigned, f); return (u + 0x7fffu + ((u >> 16) & 1u)) >> 16; }
__device__ __forceinline__ unsigned pk2(float lo, float hi) { return f2bf(lo) | (f2bf(hi) << 16); }
__device__ __forceinline__ float bflo(unsigned w) { return __uint_as_float(w << 16); }
__device__ __forceinline__ float bfhi(unsigned w) { return __uint_as_float(w & 0xffff0000u); }
__device__ __forceinline__ float wave_sum(float v) {
#pragma unroll
    for (int o = 1; o < 64; o <<= 1) v += __shfl_xor(v, o);
    return v;
}
typedef __attribute__((address_space(4))) const unsigned char* kptr_t;
struct Frame { LAS unsigned char* lds; int tid, lane, wave, vcu, cid, G; kptr_t kp; };
#define KIN(F_, i) (*(const float* const __attribute__((address_space(4)))*)((F_).kp + 8 * (i)))
#define KOUT(F_) (*(float* const __attribute__((address_space(4)))*)((F_).kp + 128))
#define KWS(F_) (*(unsigned char* const __attribute__((address_space(4)))*)((F_).kp + 136))
__device__ __forceinline__ bool relaunder(Frame& F) { int m1 = -1; asm volatile("" : "+s"(m1)); const int ln = __builtin_amdgcn_mbcnt_hi(m1, __builtin_amdgcn_mbcnt_lo(m1, 0));
    { kptr_t k = F.kp; asm volatile("" : "+s"(k)); F.kp = k; } F.lane = ln; F.tid = F.wave * 64 + ln; return true; }

struct P0Item { const float* W; bf16* WT; const float* gain; int ldw, K, N, item; };
__device__ __forceinline__ P0Item p0_decode(const Frame& F, unsigned char* ws, int it) {
    constexpr int I_WIN = (D / 64) * (4096 / 32), I_WOG = (GE / 64) * (D / 32), I_WOF = (D / 64) * (D / 32), I_W2 = (FF / 64) * (D / 32);
    P0Item q; int r = it;
    constexpr int PER_J = I_WIN + I_WOG + I_WIN + I_WOF;
    if (r < 2 * PER_J) { const int j = r / PER_J; r -= j * PER_J;
        if (r < I_WIN) { q = P0Item{KIN(F, 1) + (size_t)j * D * 4096, (bf16*)(ws + WS_WIN_G + j * 8 * MiB), KIN(F, 12) + (2 * j) * D, 4096, D, 4096, r}; return q; } r -= I_WIN;
        if (r < I_WOG) { q = P0Item{KIN(F, 6) + (size_t)j * GE * D, (bf16*)(ws + WS_WOUT_G + j * 4 * MiB), nullptr, D, GE, D, r}; return q; } r -= I_WOG;
        if (r < I_WIN) { q = P0Item{KIN(F, 7) + (size_t)j * D * FOXN, (bf16*)(ws + WS_WIN_F + j * 8 * MiB), KIN(F, 12) + (2 * j + 1) * D, FOXN, D, 4096, r}; return q; } r -= I_WIN;
        q = P0Item{KIN(F, 11) + (size_t)j * D * D, (bf16*)(ws + WS_WOUT_F + j * 2 * MiB), nullptr, D, D, D, r}; return q; }
    r -= 2 * PER_J; { const int i = r / (I_WIN + I_W2); r -= i * (I_WIN + I_W2);
        if (r < I_WIN) { q = P0Item{KIN(F, 14) + (size_t)i * D * FF, (bf16*)(ws + WS_W1 + i * 8 * MiB), KIN(F, 13) + i * D, FF, D, FF, r}; return q; } r -= I_WIN;
        q = P0Item{KIN(F, 15) + (size_t)i * FF * D, (bf16*)(ws + WS_W2 + i * 8 * MiB), nullptr, D, FF, D, r}; return q; }
}
__device__ __forceinline__ void p0_load(const P0Item& q, int lane, f32x4 (&v)[8]) {
    const int nblk = q.N / 32, kb = q.item / nblk, nb = q.item % nblk, k0 = 64 * kb, n0 = 32 * nb, c = lane & 7, n4 = lane >> 3;
    const float* src = q.W + (size_t)(k0 + 8 * c) * q.ldw + n0 + 4 * n4;
#pragma unroll
    for (int i = 0; i < 8; ++i) v[i] = __builtin_nontemporal_load((const f32x4*)(src + (size_t)i * q.ldw));
}
__device__ __forceinline__ void p0_store(const P0Item& q, int lane, f32x4 (&v)[8]) {
    const int nblk = q.N / 32, kb = q.item / nblk, nb = q.item % nblk, k0 = 64 * kb, n0 = 32 * nb, c = lane & 7, n4 = lane >> 3;
    if (q.gain) { const f32x4 g0 = *(const f32x4*)(q.gain + k0 + 8 * c), g1 = *(const f32x4*)(q.gain + k0 + 8 * c + 4);
        v[0] = v[0] * g0.x; v[1] = v[1] * g0.y; v[2] = v[2] * g0.z; v[3] = v[3] * g0.w; v[4] = v[4] * g1.x; v[5] = v[5] * g1.y; v[6] = v[6] * g1.z; v[7] = v[7] * g1.w; }
#pragma unroll
    for (int e = 0; e < 4; ++e) { v4u o; o.x = pk2(v[0][e], v[1][e]); o.y = pk2(v[2][e], v[3][e]); o.z = pk2(v[4][e], v[5][e]); o.w = pk2(v[6][e], v[7][e]);
        __builtin_nontemporal_store(o, (v4u*)(q.WT + (size_t)(n0 + 4 * n4 + e) * q.K + k0 + 8 * c)); }
}
__device__ __forceinline__ void p0_prologue(const Frame& F, unsigned char* ws) {
    const int gw = F.vcu * NWAVES + F.wave, NGW = F.G * NWAVES;
    constexpr int I_WIN = (D / 64) * (4096 / 32), I_WOG = (GE / 64) * (D / 32), I_WOF = (D / 64) * (D / 32), I_W2 = (FF / 64) * (D / 32);
    constexpr int NITEMS = 2 * (I_WIN + I_WOG + I_WIN + I_WOF) + 4 * (I_WIN + I_W2);
    for (int it = gw; it < NITEMS; it += 4 * NGW) {
        const bool h1 = it + NGW < NITEMS, h2 = it + 2 * NGW < NITEMS, h3 = it + 3 * NGW < NITEMS;
        const P0Item a = p0_decode(F, ws, it), b = p0_decode(F, ws, h1 ? it + NGW : it), c = p0_decode(F, ws, h2 ? it + 2 * NGW : it), d = p0_decode(F, ws, h3 ? it + 3 * NGW : it);
        f32x4 va[8], vb[8], vc[8], vd[8]; p0_load(a, F.lane, va); p0_load(b, F.lane, vb); p0_load(c, F.lane, vc); p0_load(d, F.lane, vd);
        p0_store(a, F.lane, va); if (h1) p0_store(b, F.lane, vb); if (h2) p0_store(c, F.lane, vc); if (h3) p0_store(d, F.lane, vd);
    }
}
__device__ __forceinline__ void p0_rows(const Frame& F, unsigned char* ws) {
    const int gw = F.vcu * NWAVES + F.wave, NGW = F.G * NWAVES;
    bf16* XN = (bf16*)(ws + WS_XN); float* xs = (float*)(ws + WS_XS);
    for (int m = gw; m < M; m += 2 * NGW) {
        const int m2 = (m + NGW < M) ? m + NGW : m;
        const f32x4* xa = (const f32x4*)(KIN(F, 0) + (size_t)m * D) + F.lane; const f32x4* xb = (const f32x4*)(KIN(F, 0) + (size_t)m2 * D) + F.lane;
        f32x4 v[4], w[4]; float sa = 0.f, sb = 0.f;
#pragma unroll
        for (int j = 0; j < 4; ++j) { v[j] = __builtin_nontemporal_load(xa + 64 * j); w[j] = __builtin_nontemporal_load(xb + 64 * j); }
#pragma unroll
        for (int j = 0; j < 4; ++j) { sa += (v[j].x * v[j].x + v[j].y * v[j].y) + (v[j].z * v[j].z + v[j].w * v[j].w); sb += (w[j].x * w[j].x + w[j].y * w[j].y) + (w[j].z * w[j].z + w[j].w * w[j].w); }
        sa = wave_sum(sa); sb = wave_sum(sb);
        unsigned long long* oa = (unsigned long long*)(XN + (size_t)m * D) + F.lane; unsigned long long* ob = (unsigned long long*)(XN + (size_t)m2 * D) + F.lane;
#pragma unroll
        for (int j = 0; j < 4; ++j) { oa[64 * j] = (unsigned long long)pk2(v[j].x, v[j].y) | ((unsigned long long)pk2(v[j].z, v[j].w) << 32); ob[64 * j] = (unsigned long long)pk2(w[j].x, w[j].y) | ((unsigned long long)pk2(w[j].z, w[j].w) << 32); }
        if (F.lane == 0) { *(f32x4*)(xs + (size_t)m * 4) = (f32x4){sa, 0.f, 0.f, 0.f}; *(f32x4*)(xs + (size_t)m2 * 4) = (f32x4){sb, 0.f, 0.f, 0.f}; }
    }
    for (int i = blockIdx.x * (NWAVES * 64) + F.tid; i < 2 * 16 * 1024; i += F.G * NWAVES * 64) { const int j = i >> 14, h = (i >> 10) & 15, k = i & 1023;
        ((bf16*)(ws + WS_WF))[i] = (bf16)f2bf(KIN(F, 7)[(size_t)j * D * FOXN + (size_t)k * FOXN + 4096 + h] * KIN(F, 12)[(2 * j + 1) * D + k]); }
}
__device__ __forceinline__ f32x4 load_rs(const Frame& F, const float* xs, int pm) {
    f32x4 a = (f32x4){1.f, 0.f, 0.f, 0.f};
    if (F.tid < 256 && pm >= 0) a = *(const f32x4*)(xs + ((size_t)pm * 256 + F.tid) * 4);
    return a;
}
__device__ __forceinline__ float qk_bound(const Frame& F, const float* qg, const float* kg) {
    float a = fabsf(qg[F.lane]), b = fabsf(kg[F.lane]);
#pragma unroll
    for (int off = 1; off < 64; off <<= 1) { a = fmaxf(a, __uint_as_float((unsigned)__builtin_amdgcn_ds_bpermute(4 * (F.lane ^ off), (int)__float_as_uint(a)))); b = fmaxf(b, __uint_as_float((unsigned)__builtin_amdgcn_ds_bpermute(4 * (F.lane ^ off), (int)__float_as_uint(b)))); }
    return __uint_as_float((unsigned)__builtin_amdgcn_readfirstlane((int)__float_as_uint(64.0f * a * b * attn_body::C2 * 1.02f + 1.0f)));
}
__device__ __forceinline__ void flogit_prestep(const Frame& F, const bf16* XN, const bf16* WF, const float* xs, const float* bfv, float* logf) {
    const int gw = F.vcu * NWAVES + F.wave, NGW = F.G * NWAVES, fr = F.lane & 15, fq = F.lane >> 4;
    for (int task = F.vcu + F.G * F.wave; task < M / 16; task += NGW) { const int r0 = 16 * (128 * ((task >> 5) & 7) + (task & 31) + 32 * (task >> 8));
        const bf16* ap = XN + (size_t)(r0 + fr) * D + 8 * fq; const bf16* bp = WF + (size_t)fr * D + 8 * fq;
        f32x4 acc = (f32x4){0.f, 0.f, 0.f, 0.f};
#pragma unroll 8
        for (int ks = 0; ks < 32; ++ks) { const bf16x8 a = *(const bf16x8*)(ap + 32 * ks), b = *(const bf16x8*)(bp + 32 * ks); acc = __builtin_amdgcn_mfma_f32_16x16x32_bf16(a, b, acc, 0, 0, 0); }
        const float bh = bfv[fr]; f32x4 lf;
#pragma unroll
        for (int e = 0; e < 4; ++e) { const f32x4 a = *(const f32x4*)(xs + (size_t)(r0 + 4 * fq + e) * 4);
            const float tot = (a[0] + a[1]) + (a[2] + a[3]);
            const float z = acc[e] / sqrtf(tot * (1.0f / D) + RMS_EPS) + bh; lf[e] = fminf(z, 0.f) - 0.6931471805599453f * __builtin_amdgcn_logf(1.0f + __builtin_amdgcn_exp2f(-1.4426950408889634f * fabsf(z))); }
        const int row = r0 + 4 * fq;
        *(f32x4*)(logf + ((size_t)((row >> 11) * 16 + fr)) * SEQ + (row & (SEQ - 1))) = lf;
    }
}
__device__ __forceinline__ void spatial_phase(const Frame& F, bf16* Z, const float* stats, const float* lng, const float* lnb, const float* ws, const float* bs, bool do_store = true) {
    constexpr int LST = 272;
    LAS unsigned char* Wl = F.lds; LAS unsigned char* Vt = F.lds + 128 * LST; LAS float* st = (LAS float*)(F.lds + 128 * LST + 256 * LST);
    const int tid = F.tid, lane = F.lane, w = F.wave, fr = lane & 15, fq = lane >> 4;
    int staged_g = -1;
    for (int unit = F.vcu; unit < (M / 128) * 8; unit += F.G) {
        const int g = unit & 7, chunk = 16 * ((unit >> 5) & 7) + ((unit & 31) >> 3) + 4 * (unit >> 8); const size_t row0 = (size_t)chunk * 128;
        f32x4 sq[16];
        if (tid < 128) { const f32x4* sp = (const f32x4*)(stats + (row0 + tid) * 64);
#pragma unroll
            for (int i = 0; i < 16; ++i) sq[i] = sp[i]; }
        const bf16* va = Z + (row0 + 2 * lane) * 4096 + 2048 + 256 * g + 32 * w;
        v4u rawA[4], rawB[4];
#pragma unroll
        for (int it = 0; it < 4; ++it) { rawA[it] = *(const v4u*)(va + 8 * it); rawB[it] = *(const v4u*)(va + 4096 + 8 * it); }
        v2u uu[8][2];
#pragma unroll
        for (int m = 0; m < 8; ++m)
#pragma unroll
            for (int n = 0; n < 2; ++n) uu[m][n] = *(const v2u*)(Z + (row0 + 16 * m + fr) * 4096 + 256 * g + 32 * w + 16 * n + 4 * fq);
        if (tid < 128) { float s1 = 0.f, s2 = 0.f;
#pragma unroll
            for (int i = 0; i < 16; ++i) { const f32x4 q = sq[i]; s1 += q.x + q.z; s2 += q.y + q.w; }
            const float mean = s1 * (1.0f / GE); const float var = fmaxf(s2 * (1.0f / GE) - mean * mean, 0.f);
            st[2 * tid] = mean; st[2 * tid + 1] = 1.0f / sqrtf(var + LN_EPS); }
        if (g != staged_g) { staged_g = g; const float* wg = ws + (size_t)g * 128 * 128;
#pragma unroll
            for (int i = 0; i < 8; ++i) { const int p = tid + 512 * i, t = p >> 5, s4 = (p & 31) * 4; f32x4 x = *(const f32x4*)(wg + t * 128 + s4);
                if (s4 + 0 > t) x.x = 0.f; if (s4 + 1 > t) x.y = 0.f; if (s4 + 2 > t) x.z = 0.f; if (s4 + 3 > t) x.w = 0.f;
                *(LAS v2u*)(Wl + t * LST + s4 * 2) = (v2u){pk2(x.x, x.y), pk2(x.z, x.w)}; } }
        __syncthreads();
        {
            const float meanA = st[4 * lane], rstdA = st[4 * lane + 1], meanB = st[4 * lane + 2], rstdB = st[4 * lane + 3];
#pragma unroll
            for (int it = 0; it < 4; ++it) { const int c0 = 32 * w + 8 * it;
                const f32x4 ga = *(const f32x4*)(lng + 256 * g + c0), gb = *(const f32x4*)(lng + 256 * g + c0 + 4), ba = *(const f32x4*)(lnb + 256 * g + c0), bb = *(const f32x4*)(lnb + 256 * g + c0 + 4);
                const float lg[8] = {ga.x, ga.y, ga.z, ga.w, gb.x, gb.y, gb.z, gb.w}, lb[8] = {ba.x, ba.y, ba.z, ba.w, bb.x, bb.y, bb.z, bb.w};
#pragma unroll
                for (int e = 0; e < 8; ++e) { const unsigned wa = rawA[it][e >> 1], wb = rawB[it][e >> 1]; const float xa = (e & 1) ? bfhi(wa) : bflo(wa), xb = (e & 1) ? bfhi(wb) : bflo(wb);
                    const float ya = (xa - meanA) * rstdA * lg[e] + lb[e], yb = (xb - meanB) * rstdB * lg[e] + lb[e];
                    *(LAS unsigned*)(Vt + (c0 + e) * LST + 4 * lane) = pk2(ya, yb); } } }
        __syncthreads();
        f32x4 acc[8][2];
#pragma unroll
        for (int m = 0; m < 8; ++m) { acc[m][0] = (f32x4){0.f, 0.f, 0.f, 0.f}; acc[m][1] = (f32x4){0.f, 0.f, 0.f, 0.f}; }
#pragma unroll
        for (int ks = 0; ks < 4; ++ks) { bf16x8 Bf[2];
#pragma unroll
            for (int n = 0; n < 2; ++n) Bf[n] = *(const LAS bf16x8*)(Vt + (32 * w + 16 * n + fr) * LST + (ks * 32 + fq * 8) * 2);
#pragma unroll
            for (int m = 0; m < 8; ++m) if (32 * ks <= 16 * m + 15) { const bf16x8 Af = *(const LAS bf16x8*)(Wl + (16 * m + fr) * LST + (ks * 32 + fq * 8) * 2);
#pragma unroll
                for (int n = 0; n < 2; ++n) acc[m][n] = __builtin_amdgcn_mfma_f32_16x16x32_bf16(Bf[n], Af, acc[m][n], 0, 0, 0); } }
#pragma unroll
        for (int m = 0; m < 8; ++m) { const int t = 16 * m + fr; const float b = bs[g * 128 + t];
#pragma unroll
            for (int n = 0; n < 2; ++n) { const int c = 32 * w + 16 * n + 4 * fq; v2u* p = (v2u*)(Z + (row0 + t) * 4096 + 256 * g + c); const v2u u2 = uu[m][n];
                const float o0 = bflo(u2.x) * (acc[m][n][0] + b), o1 = bfhi(u2.x) * (acc[m][n][1] + b), o2 = bflo(u2.y) * (acc[m][n][2] + b), o3 = bfhi(u2.y) * (acc[m][n][3] + b);
                if (do_store) *p = (v2u){pk2(o0, o1), pk2(o2, o3)}; } }
        __syncthreads();
    }
}
#define XB_TMO      128
#define XB_XCNT(j)  (256  + 64 * (j))
#define XB_XSUB(j)  (1280 + 64 * (j))
#define XB_XGEN(j)  (2304 + 64 * (j))
#define XB_TOP      3328
#define XB_TOPGEN   3392
#define XCD_BAR_WORDS 3456
#define XB_SPIN_CAP (1u << 18)

__device__ __forceinline__ unsigned xb_ld(unsigned* p)              { return __hip_atomic_load(p, __ATOMIC_RELAXED, __HIP_MEMORY_SCOPE_AGENT); }
__device__ __forceinline__ unsigned xb_add(unsigned* p, unsigned v) { return __hip_atomic_fetch_add(p, v, __ATOMIC_RELAXED, __HIP_MEMORY_SCOPE_AGENT); }
__device__ __forceinline__ unsigned xb_xcc_id() { return (unsigned)__builtin_amdgcn_s_getreg((3 << 11) | 20) & 0xFu; }
#define XB_SPIN(cond, bar) do { unsigned _sp = 0; while (cond) { __builtin_amdgcn_s_sleep(1); \
    if ((++_sp & 255u) == 0u) { if (xb_ld(&(bar)[XB_TMO])) break; if (_sp > XB_SPIN_CAP) { atomicAdd(&(bar)[XB_TMO], 1u); break; } } } } while (0)

struct XcdBarrier {
    unsigned* bar; unsigned x;
    volatile LAS unsigned* st;
};

__device__ __forceinline__ XcdBarrier xcd_barrier_post(unsigned* bar, volatile LAS unsigned* st) {
    XcdBarrier b; b.bar = bar; b.x = xb_xcc_id(); b.st = st;
    if (threadIdx.x == 0) st[3] = xb_add(&bar[XB_XCNT(b.x)], 1u);
    return b;
}
__device__ __forceinline__ void xcd_barrier_complete(unsigned* bar, unsigned x, unsigned& nloc, unsigned& nx, unsigned& uni) {
    const unsigned G = gridDim.x * gridDim.y * gridDim.z;
    unsigned sum, cnt, mine, sp = 0u;
    for (;;) {
        sum = 0u; cnt = 0u; mine = 0u;
#pragma unroll
        for (unsigned j = 0; j < 16; ++j) { const unsigned c = xb_ld(&bar[XB_XCNT(j)]); sum += c; cnt += (c > 0u) ? 1u : 0u; mine = (j == x) ? c : mine; }
        if (sum == G) break;
        __builtin_amdgcn_s_sleep(1);
        if ((++sp & 255u) == 0u) { if (xb_ld(&bar[XB_TMO])) break; if (sp > XB_SPIN_CAP) { atomicAdd(&bar[XB_TMO], 1u); break; } }
    }
    nloc = mine > 0u ? mine : 1u; nx = cnt > 0u ? cnt : 1u;
    unsigned ok = (sum == G && G == 256u && cnt == 8u) ? 1u : 0u, rank = 0u;
#pragma unroll
    for (unsigned j = 0; j < 16; ++j) { const unsigned c = xb_ld(&bar[XB_XCNT(j)]); if (c != 0u && c != 32u) ok = 0u; if (j < x && c > 0u) ++rank; }
    uni = ok ? 1u + rank : 0u;
}

__device__ __forceinline__ void xcd_barrier(const XcdBarrier& b, const bool local_only = false) {
    asm volatile("s_waitcnt vmcnt(0)" ::: "memory");
    __syncthreads();
    if (threadIdx.x == 0) {
        unsigned* bar = b.bar;
        __builtin_amdgcn_s_waitcnt(0);
        unsigned nloc = b.st[0], nx = b.st[1];
        if (nloc == 0u) { unsigned uni; xcd_barrier_complete(bar, b.x, nloc, nx, uni); b.st[0] = nloc; b.st[1] = nx; b.st[2] = uni; }
        const unsigned old = xb_add(&bar[XB_XSUB(b.x)], 1u);
        const unsigned gen = old / nloc;
        if (old + 1u == (gen + 1u) * nloc) {
            if (!local_only) {
            __builtin_amdgcn_fence(__ATOMIC_RELEASE, "agent");
            asm volatile("s_waitcnt vmcnt(0)" ::: "memory");
            const unsigned og = xb_add(&bar[XB_TOP], 1u);
            const unsigned tg = og / nx;
            if (og + 1u == (tg + 1u) * nx) xb_add(&bar[XB_TOPGEN], 1u);
            else XB_SPIN(xb_ld(&bar[XB_TOPGEN]) == tg, bar);
            }
            __builtin_amdgcn_fence(__ATOMIC_ACQUIRE, "agent");
            xb_add(&bar[XB_XGEN(b.x)], 1u);
            asm volatile("s_waitcnt vmcnt(0)" ::: "memory");
        } else {
            XB_SPIN(xb_ld(&bar[XB_XGEN(b.x)]) == gen, bar);
            __builtin_amdgcn_fence(__ATOMIC_ACQUIRE, "agent");
            asm volatile("s_waitcnt vmcnt(0)" ::: "memory");
        }
    }
    __syncthreads();
}
constexpr int CW_BAR = 1024;
struct Args { const float* in[16]; float* out; unsigned char* ws; int ph_lo, ph_hi; };
__global__ void __launch_bounds__(NWAVES * 64, 2) mk_fwd(Args args) {
    extern __shared__ __attribute__((aligned(16))) unsigned char lds[];
    Frame F; F.lds = (LAS unsigned char*)lds; F.wave = __builtin_amdgcn_readfirstlane((int)threadIdx.x >> 6); F.lane = 0; F.tid = 0; relaunder(F);
    F.G = gridDim.x; { const int bx = blockIdx.x; F.vcu = (F.G % 8 == 0) ? (bx % 8) * (F.G / 8) + bx / 8 : bx; } F.cid = (int)blockIdx.x;
    F.kp = (kptr_t)__builtin_amdgcn_kernarg_segment_ptr();
    volatile LAS unsigned* bst = (volatile LAS unsigned*)(F.lds + 131072);
    if (F.tid == 0) { bst[0] = 0u; bst[1] = 0u; bst[2] = 0u; bst[3] = 0u; }
    __syncthreads();
    XcdBarrier bar; bar.bar = (unsigned*)(KWS(F) + WS_CTL) + CW_BAR; bar.x = 0; bar.st = bst;
    if (args.ph_hi - args.ph_lo > 1) bar = xcd_barrier_post((unsigned*)(KWS(F) + WS_CTL) + CW_BAR, bst);
    const int lo = args.ph_lo, hi = args.ph_hi; int ph = 0;
    if (hi - lo > 1) cg::this_grid().sync();
#define REP(n) for (int rep_ = 0; rep_ < (n); ++rep_)
#define ws KWS(F)
#define out KOUT(F)
#define stats ((float*)(KWS(F) + WS_STATS))
#define logf ((float*)(KWS(F) + WS_LOGF))
#define XN ((bf16*)(KWS(F) + WS_XN))
#define BIG ((bf16*)(KWS(F) + WS_BIG))
#define xs ((float*)(KWS(F) + WS_XS))
#define IN_PH() (lo <= ph && ph < hi && relaunder(F))
#define END_PH() do { if (ph + 1 < hi) { bar.bar = (unsigned*)(KWS(F) + WS_CTL) + CW_BAR; xcd_barrier(bar, xlocal); } } while (0)
    bool xlocal = false;
    if (IN_PH()) { REP(RP_P0) { p0_prologue(F, KWS(F)); p0_rows(F, KWS(F)); } END_PH(); } ++ph;
    if (hi - lo > 1 && lo == 0) { const unsigned uni = __builtin_amdgcn_readfirstlane(bst[2]), lidx = __builtin_amdgcn_readfirstlane(bst[3]);
        if (uni != 0u && lidx < 32u) { xlocal = true; F.vcu = (int)((uni - 1u) * 32u + lidx); F.cid = (int)(lidx * 8u + (uni - 1u)); } }
    if (hi - lo > 1) { REP(RP_BAR) { bar.bar = (unsigned*)(KWS(F) + WS_CTL) + CW_BAR; xcd_barrier(bar); } }
    for (int L = 0; L < 4; ++L) {
        const int j = L >> 1; const bool fox = (L & 1) != 0;
        if (!fox) {
            if (IN_PH()) { pg8::Gemm g{XN, (const bf16*)(ws + WS_WIN_G + j * 8 * MiB), M, 4096, D, D, 0}; pg8::StaticOrder S; S.init(M, 4096, F.G, F.cid); pg8::Unit u0_; const int pm0_ = S.next(0, u0_) ? u0_.pm : -1; const f32x4 rsr_ = load_rs(F, xs, pm0_);
                pg8::EpiBf16<1> E{BIG, 4096, 0, 0, stats, 8, xs, (const LAS float*)(F.lds + 131072 + 8704), pm0_, rsr_, (LAS float*)(F.lds + 131072 + 8704)};
                REP(RP_G4) pg8::gemm_phase<pg8::EpiBf16<1>, pg8::StaticOrder, PG8_ALIGN, PG8_SP2>(F.lds, g, S, E, F.tid); END_PH(); } ++ph;
            if (IN_PH()) { REP(RP_SP) spatial_phase(F, BIG, stats, KIN(F, 2) + j * GE, KIN(F, 3) + j * GE, KIN(F, 4) + (size_t)j * 8 * 128 * 128, KIN(F, 5) + j * 8 * 128, rep_ + lo >= RP_SP - 1); END_PH(); } ++ph;
            if (IN_PH()) { pg8::Gemm g{BIG, (const bf16*)(ws + WS_WOUT_G + j * 4 * MiB), M, D, GE, 4096, 0}; pg8::StaticOrder S; S.init(M, D, F.G, F.cid);
                { pg8::EpiRes E{(const float*)nullptr, (float*)nullptr, XN, xs, D, (LAS float*)(F.lds + 131072 + 256)}; pg8::gemm_phase<pg8::EpiRes, pg8::StaticOrder, true, PG8_SP2>(F.lds, g, S, E, F.tid); } END_PH(); } ++ph;
        } else {
            bf16* Qb = BIG; bf16* Kb = BIG + (size_t)SEQ * D; bf16* Vb = BIG + 2 * (size_t)SEQ * D; bf16* Gb = BIG + 3 * (size_t)SEQ * D;
            if (IN_PH()) { flogit_prestep(F, XN, (const bf16*)(ws + WS_WF) + (size_t)j * 16 * D, xs, KIN(F, 8) + j * 16, logf);
                pg8::Gemm g{XN, (const bf16*)(ws + WS_WIN_F + j * 8 * MiB), M, 4096, D, D, 0}; pg8::StaticOrder S; S.init(M, 4096, F.G, F.cid); pg8::Unit u0_; const int pm0_ = S.next(0, u0_) ? u0_.pm : -1; const f32x4 rsr_ = load_rs(F, xs, pm0_);
                pg8::EpiQKVG E{BIG, D, (size_t)SEQ * D, xs, KIN(F, 9) + j * 64, KIN(F, 10) + j * 64, (LAS float*)(F.lds + 131072 + 256), attn_body::C2, (const LAS float*)(F.lds + 131072 + 8704), pm0_, (size_t)3 * SEQ * D, rsr_, (LAS float*)(F.lds + 131072 + 8704)};
                REP(RP_G4) pg8::gemm_phase<pg8::EpiQKVG, pg8::StaticOrder, true, PG8_SP2>(F.lds, g, S, E, F.tid); END_PH(); } ++ph;
            if (IN_PH()) { const attn_body::AttnTensors AT{(const attn_body::bf16*)Qb, (const attn_body::bf16*)Kb, (const attn_body::bf16*)Vb, (attn_body::bf16*)Qb, (const attn_body::bf16*)Gb, logf, qk_bound(F, KIN(F, 9) + j * 64, KIN(F, 10) + j * 64)};
                const attn_body::StaticOrder S(F.G, F.vcu);
                attn_body::attn_phase<attn_body::StaticOrder>((char*)lds, AT, S, F.tid); END_PH(); } ++ph;
            if (IN_PH()) { pg8::Gemm g{Qb, (const bf16*)(ws + WS_WOUT_F + j * 2 * MiB), M, D, D, D, (size_t)3 * SEQ * D * 2};     pg8::StaticOrder S; S.init(M, D, F.G, F.cid);
                { pg8::EpiRes E{(const float*)nullptr, (float*)nullptr, XN, xs, D, (LAS float*)(F.lds + 131072 + 256)}; pg8::gemm_phase<pg8::EpiRes, pg8::StaticOrder, true, PG8_SP2>(F.lds, g, S, E, F.tid); } END_PH(); } ++ph;
        }
        if (IN_PH()) { pg8::Gemm g{XN, (const bf16*)(ws + WS_W1 + L * 8 * MiB), M, FF, D, D, 0}; pg8::StaticOrder S; S.init(M, FF, F.G, F.cid); pg8::Unit u0_; const int pm0_ = S.next(0, u0_) ? u0_.pm : -1; const f32x4 rsr_ = load_rs(F, xs, pm0_);
            pg8::EpiBf16<2> E{BIG, FF, 0, 0, nullptr, 0, xs, (const LAS float*)(F.lds + 131072 + 8704), pm0_, rsr_, (LAS float*)(F.lds + 131072 + 8704)};
            REP(RP_G4) pg8::gemm_phase<pg8::EpiBf16<2>, pg8::StaticOrder, PG8_ALIGN, PG8_SP2>(F.lds, g, S, E, F.tid); END_PH(); } ++ph;
        if (IN_PH()) { pg8::Gemm g{BIG, (const bf16*)(ws + WS_W2 + L * 8 * MiB), M, D, FF, FF, 0}; pg8::StaticOrder S; S.init(M, D, F.G, F.cid);
            { pg8::EpiRes E{(const float*)nullptr, (L == 3) ? out : (float*)nullptr, XN, xs, D, (LAS float*)(F.lds + 131072 + 256)}; pg8::gemm_phase<pg8::EpiRes, pg8::StaticOrder, true, PG8_SP2>(F.lds, g, S, E, F.tid); } END_PH(); } ++ph;
    }
#undef IN_PH
#undef ws
#undef out
#undef stats
#undef logf
#undef XN
#undef BIG
#undef xs
#undef END_PH
}

extern "C" void kernel_launch(void* const* d_in, const int* in_sizes, int n_in, void* d_out, int out_size, void* d_ws, size_t ws_size, hipStream_t stream) {
    static int grid = 0;
    if (grid == 0) {
        if (n_in != 16 || out_size != M * D || ws_size < WS_END) { fprintf(stderr, "kernel_launch: unexpected shapes: n_in %d out %d ws %zu (need %zu)\n", n_in, out_size, ws_size, (size_t)WS_END); grid = -1; return; }
        int dev = 0, cus = 0, per_cu = 0;
        if (hipGetDevice(&dev) != hipSuccess || hipDeviceGetAttribute(&cus, hipDeviceAttributeMultiprocessorCount, dev) != hipSuccess) { grid = -1; return; }
        if (hipFuncSetAttribute((const void*)mk_fwd, hipFuncAttributeMaxDynamicSharedMemorySize, LDS_BYTES) != hipSuccess) { fprintf(stderr, "kernel_launch: hipFuncSetAttribute failed\n"); grid = -1; return; }
        if (hipOccupancyMaxActiveBlocksPerMultiprocessor(&per_cu, (const void*)mk_fwd, NWAVES * 64, LDS_BYTES) != hipSuccess || per_cu < 1) { fprintf(stderr, "kernel_launch: occupancy query says %d blocks/CU\n", per_cu); per_cu = 1; }
        (void)hipGetLastError();
        grid = cus;
    }
    if (grid < 0) return;
    if (hipMemsetAsync((char*)d_ws + WS_CTL, 0, 65536, stream) != hipSuccess) { fprintf(stderr, "kernel_launch: hipMemsetAsync failed\n"); return; }
    Args a{};
    for (int i = 0; i < 16; ++i) a.in[i] = (const float*)d_in[i];
    a.out = (float*)d_out; a.ws = (unsigned char*)d_ws;
#if MK_ONE_LAUNCH
    a.ph_lo = 0; a.ph_hi = NPHASES;
    void* params[] = {&a};
    hipError_t e = hipLaunchCooperativeKernel((const void*)mk_fwd, dim3(grid), dim3(NWAVES * 64), params, LDS_BYTES, stream);
    if (e != hipSuccess) fprintf(stderr, "kernel_launch: cooperative launch failed: %s (grid %d)\n", hipGetErrorString(e), grid);
#else
    for (int p = 0; p < NPHASES; ++p) { a.ph_lo = p; a.ph_hi = p + 1; hipLaunchKernelGGL(mk_fwd, dim3(grid), dim3(NWAVES * 64), LDS_BYTES, stream, a); }
#endif
}
```

```cpp
#include <hip/hip_runtime.h>
#include <hip/hip_cooperative_groups.h>
#include <cstdio>
#include <cstdint>
#ifndef PG8_SP2
#define PG8_SP2 true
#endif
#ifndef PG8_ALIGN
#define PG8_ALIGN true
#endif
#ifndef MK_ONE_LAUNCH
#define MK_ONE_LAUNCH 1
#endif
#ifndef RP_P0
#define RP_P0 1
#endif
#ifndef RP_G4
#define RP_G4 1
#endif
#ifndef RP_SP
#define RP_SP 1
#endif
#ifndef RP_BAR
#define RP_BAR 0
#endif
namespace pg8 {
#define PG8_LAS __attribute__((address_space(3)))
typedef unsigned short bf16_t;
typedef short bf16x8 __attribute__((ext_vector_type(8)));
typedef float f32x4 __attribute__((ext_vector_type(4)));
typedef unsigned u32x4 __attribute__((ext_vector_type(4)));
constexpr int BM = 256, BK = 64, HALF = 128, HTB = HALF * BK * 2  , STAGE_BYTES = 8 * HTB, NXCD = 8, WGM = 8;

__host__ __device__ __forceinline__ int lds_byte(int r, int c) { const int st = (r >> 4) * 2 + (c >> 5), rr = r & 15, cc = c & 31, ob = rr * 64 + cc * 2; return st * 1024 + (ob ^ (((ob >> 9) & 1) << 5)); }
__host__ __device__ __forceinline__ void stage_rc(int b, int& R, int& C) { const int st = b / 1024, sb = b % 1024, swz = sb ^ (((sb >> 9) & 1) << 5); R = (st >> 1) * 16 + swz / 64; C = (st & 1) * 32 + (swz % 64) / 2; }
__host__ __device__ __forceinline__ int perm32(int rho) { const int n = rho >> 4, i = rho & 15; return 8 * (i >> 2) + 4 * n + (i & 3); }

struct Unit { int pm, pn; };
struct Gemm { const bf16_t* A; const bf16_t* Bt; int M, N, K, lda; size_t abx; };

struct StaticOrder {
    int nM, nN, nwg, G, c;
    __host__ __device__ __forceinline__ void init(int M, int N, int G_, int c_) { nM = M / BM; nN = N / BM; nwg = nM * nN; G = G_; c = c_; }
    __host__ __device__ __forceinline__ bool next(int i, Unit& u) const {
        const long L = (long)i * G + c; if (L >= nwg) return false;
        int wgid = (int)L; { const int q = nwg / NXCD, r = nwg % NXCD, xcd = wgid % NXCD, off = wgid / NXCD; wgid = (xcd < r ? xcd * (q + 1) : r * (q + 1) + (xcd - r) * q) + off; }
        const int nig = WGM * nN, gid = wgid / nig, fm = gid * WGM, gsz = (nM - fm) < WGM ? (nM - fm) : WGM;
        u.pm = fm + ((wgid % nig) % gsz); u.pn = (wgid % nig) / gsz; return true;
    }
    __device__ __forceinline__ void a_ready(const Unit&) const {}
    __device__ __forceinline__ void done(const Unit&) const {}
};
__device__ __forceinline__ unsigned cvt_pk_bf16(float lo, float hi) { unsigned r; asm volatile("v_cvt_pk_bf16_f32 %0, %1, %2" : "=v"(r) : "v"(lo), "v"(hi)); return r; }
__device__ __forceinline__ float fq_sum(float v) {
    { const auto r = __builtin_amdgcn_permlane16_swap(__float_as_uint(v), __float_as_uint(v), false, false); v = __uint_as_float(r[0]) + __uint_as_float(r[1]); }
    { const auto r = __builtin_amdgcn_permlane32_swap(__float_as_uint(v), __float_as_uint(v), false, false); v = __uint_as_float(r[0]) + __uint_as_float(r[1]); }
    return v;
}
__device__ __forceinline__ float gelu_tanh(float x) {
    const float u = x * (1.0f + 0.044715f * x * x);
    const float e = __builtin_amdgcn_exp2f(-2.3022081985f * u);
    return x * __builtin_amdgcn_rcpf(1.0f + e);
}
typedef float f32x2 __attribute__((ext_vector_type(2)));
template <int ACT> struct EpiBf16 {
    static constexpr bool PERM = true, AFTER_DRAIN = false, HAS_INIT = false, HAS_PRE = true;
    bf16_t* O; int ldc; int split_cols; size_t split_stride; float* stats; int stats_pn0; const float* xs; const PG8_LAS float* rsl; int rs_pm;
    f32x4 rs_raw; PG8_LAS float* rsl_w;
    __device__ __forceinline__ void pre(int tid) const { if (tid < BM) rsl_w[tid] = 1.0f / sqrtf(((rs_raw[0] + rs_raw[1]) + (rs_raw[2] + rs_raw[3])) * (1.0f / 1024.0f) + 1e-6f); }
    __device__ __forceinline__ void operator()(const f32x4 (&acc)[2][2][4][2], const Unit& u, int wr, int wc, int fr, int fq) const {
        const int row0 = u.pm * BM + wr * 64 + fr; int colt = u.pn * BM; bf16_t* base = O;
        if (split_cols) { const int t = colt / split_cols; base += (size_t)t * split_stride; colt -= t * split_cols; }
        const int col0 = colt + wc * 32 + 8 * fq;
        const bool do_stats = (ACT == 1) && (u.pn >= stats_pn0);
        float rsv[2][4];
        if (u.pm == rs_pm) {
#pragma unroll
          for (int ai = 0; ai < 2; ++ai)
#pragma unroll
            for (int m = 0; m < 4; ++m) rsv[ai][m] = rsl[wr * 64 + fr + ai * HALF + m * 16];
        } else { f32x4 xq[2][4];
#pragma unroll
          for (int ai = 0; ai < 2; ++ai)
#pragma unroll
            for (int m = 0; m < 4; ++m) xq[ai][m] = *(const f32x4*)(xs + (size_t)(row0 + ai * HALF + m * 16) * 4);
#pragma unroll
          for (int ai = 0; ai < 2; ++ai)
#pragma unroll
            for (int m = 0; m < 4; ++m) rsv[ai][m] = 1.0f / sqrtf(((xq[ai][m][0] + xq[ai][m][1]) + (xq[ai][m][2] + xq[ai][m][3])) * (1.0f / 1024.0f) + 1e-6f); }
#pragma unroll
        for (int ai = 0; ai < 2; ++ai)
#pragma unroll
            for (int m = 0; m < 4; ++m) { const int row = row0 + ai * HALF + m * 16; bf16_t* rowp = base + (size_t)row * ldc + col0; float s1 = 0.f, s2 = 0.f;
                const float rs = rsv[ai][m];
#pragma unroll
                for (int bj = 0; bj < 2; ++bj) { f32x4 v0 = acc[ai][bj][m][0] * rs, v1 = acc[ai][bj][m][1] * rs;
                    if (ACT == 1) {
#pragma unroll
                        for (int e = 0; e < 4; ++e) { v0[e] = gelu_tanh(v0[e]); v1[e] = gelu_tanh(v1[e]); }
                        s1 += ((v0[0] + v0[1]) + (v0[2] + v0[3])) + ((v1[0] + v1[1]) + (v1[2] + v1[3]));
                        s2 += ((v0[0] * v0[0] + v0[1] * v0[1]) + (v0[2] * v0[2] + v0[3] * v0[3])) + ((v1[0] * v1[0] + v1[1] * v1[1]) + (v1[2] * v1[2] + v1[3] * v1[3]));
                    }
                    if (ACT == 2) {
#pragma unroll
                        for (int e = 0; e < 4; ++e) { const float a = __builtin_fmaxf(v0[e], 0.f), b = __builtin_fmaxf(v1[e], 0.f); v0[e] = a * a; v1[e] = b * b; }
                    }
                    u32x4 w; w.x = cvt_pk_bf16(v0[0], v0[1]); w.y = cvt_pk_bf16(v0[2], v0[3]); w.z = cvt_pk_bf16(v1[0], v1[1]); w.w = cvt_pk_bf16(v1[2], v1[3]);
                    *(u32x4*)(rowp + bj * HALF) = w; }
                if (ACT == 1) { if (do_stats) {
                    s1 = fq_sum(s1); s2 = fq_sum(s2);
                    if (fq == 0) *(f32x2*)(stats + ((size_t)row * 32 + (u.pn - stats_pn0) * 4 + wc) * 2) = (f32x2){s1, s2}; } }
            }
    }
};
struct EpiQKVG {
    static constexpr bool PERM = true, AFTER_DRAIN = false, HAS_INIT = false, HAS_PRE = true;
    bf16_t* O; int ldc; size_t split_stride; const float* xs; const float* qg; const float* kg; PG8_LAS float* xl; float qscale; const PG8_LAS float* rsl; int rs_pm; size_t batch_extra;
    f32x4 rs_raw; PG8_LAS float* rsl_w;
    __device__ __forceinline__ void pre(int tid) const { if (tid < BM) rsl_w[tid] = 1.0f / sqrtf(((rs_raw[0] + rs_raw[1]) + (rs_raw[2] + rs_raw[3])) * (1.0f / 1024.0f) + 1e-6f); }

    __device__ __forceinline__ void operator()(const f32x4 (&acc)[2][2][4][2], const Unit& u, int wr, int wc, int fr, int fq) const {
        const int row0 = u.pm * BM + wr * 64 + fr; const int t = u.pn >> 2; bf16_t* base = O + (size_t)t * split_stride + (size_t)(u.pm >> 3) * batch_extra;
        const int col0 = (u.pn & 3) * BM + wc * 32 + 8 * fq;
        float rsv[2][4];
        if (u.pm == rs_pm) {
#pragma unroll
          for (int ai = 0; ai < 2; ++ai)
#pragma unroll
            for (int m = 0; m < 4; ++m) rsv[ai][m] = rsl[wr * 64 + fr + ai * HALF + m * 16];
        } else
#pragma unroll
        for (int ai = 0; ai < 2; ++ai) { f32x4 xq[4];
#pragma unroll
            for (int m = 0; m < 4; ++m) xq[m] = *(const f32x4*)(xs + (size_t)(row0 + ai * HALF + m * 16) * 4);
#pragma unroll
            for (int m = 0; m < 4; ++m) rsv[ai][m] = 1.0f / sqrtf(((xq[m][0] + xq[m][1]) + (xq[m][2] + xq[m][3])) * (1.0f / 1024.0f) + 1e-6f);
            asm volatile("" ::: "memory"); }
        if (t < 2) {
#pragma unroll
            for (int ai = 0; ai < 2; ++ai)
#pragma unroll
                for (int m = 0; m < 4; ++m)
#pragma unroll
                    for (int bj = 0; bj < 2; ++bj) { const f32x4 v0 = acc[ai][bj][m][0], v1 = acc[ai][bj][m][1];
                        float ss = ((v0[0] * v0[0] + v0[1] * v0[1]) + (v0[2] * v0[2] + v0[3] * v0[3])) + ((v1[0] * v1[0] + v1[1] * v1[1]) + (v1[2] * v1[2] + v1[3] * v1[3]));
                        ss = fq_sum(ss); ss *= rsv[ai][m] * rsv[ai][m];
                        if (fq == 0) xl[((ai * HALF + wr * 64 + m * 16 + fr) * 2 + bj) * 4 + wc] = ss; asm volatile("" ::: "memory"); }
            asm volatile("s_waitcnt lgkmcnt(0)" ::: "memory"); __builtin_amdgcn_s_barrier(); asm volatile("" ::: "memory");
            const float* gp = (t == 0 ? qg : kg) + 32 * (wc & 1) + 8 * fq; const f32x4 g0 = *(const f32x4*)gp, g1 = *(const f32x4*)(gp + 4); const float sc = (t == 0) ? qscale : 1.0f;
#pragma unroll
            for (int ai = 0; ai < 2; ++ai)
#pragma unroll
                for (int m = 0; m < 4; ++m) { const int rl = ai * HALF + wr * 64 + m * 16 + fr; bf16_t* rowp = base + (size_t)(u.pm * BM + rl) * ldc + col0;
#pragma unroll
                    for (int bj = 0; bj < 2; ++bj) { const f32x2 pr = *(const PG8_LAS f32x2*)(xl + (rl * 2 + bj) * 4 + (wc & 2)); const float tot = pr[0] + pr[1];
                        const float hr = sc * rsv[ai][m] / sqrtf(tot * (1.0f / 64.0f) + 1e-6f);
                        const f32x4 v0 = acc[ai][bj][m][0] * hr * g0, v1 = acc[ai][bj][m][1] * hr * g1;
                        u32x4 w; w.x = cvt_pk_bf16(v0[0], v0[1]); w.y = cvt_pk_bf16(v0[2], v0[3]); w.z = cvt_pk_bf16(v1[0], v1[1]); w.w = cvt_pk_bf16(v1[2], v1[3]);
                        *(u32x4*)(rowp + bj * HALF) = w; }
                    asm volatile("" ::: "memory"); }
        } else {
#pragma unroll
            for (int ai = 0; ai < 2; ++ai)
#pragma unroll
                for (int m = 0; m < 4; ++m) { bf16_t* rowp = base + (size_t)(row0 + ai * HALF + m * 16) * ldc + col0; const float rs = rsv[ai][m];
#pragma unroll
                    for (int bj = 0; bj < 2; ++bj) { const f32x4 v0 = acc[ai][bj][m][0] * rs, v1 = acc[ai][bj][m][1] * rs;
                        u32x4 w; w.x = cvt_pk_bf16(v0[0], v0[1]); w.y = cvt_pk_bf16(v0[2], v0[3]); w.z = cvt_pk_bf16(v1[0], v1[1]); w.w = cvt_pk_bf16(v1[2], v1[3]);
                        *(u32x4*)(rowp + bj * HALF) = w; } }
        }
    }
};
struct EpiRes {
    static constexpr bool PERM = true, AFTER_DRAIN = false, HAS_INIT = true, HAS_PRE = false;
    const float* base32; float* out32; bf16_t* xn; float* xs; int ldc; PG8_LAS float* xl;
    __device__ __forceinline__ void init_slow(f32x4 (&acc)[2][2][4][2], const Unit& u, int wr, int wc, int fr, int fq) const {
        const int col0 = u.pn * BM + wc * 32 + 8 * fq;
#pragma unroll
        for (int ai = 0; ai < 2; ++ai)
#pragma unroll
            for (int m = 0; m < 4; ++m) { const size_t off = (size_t)(u.pm * BM + ai * HALF + wr * 64 + m * 16 + fr) * ldc + col0;
#pragma unroll
                for (int bj = 0; bj < 2; ++bj) { const size_t p = off + bj * HALF;
                    if (base32) { acc[ai][bj][m][0] = *(const f32x4*)(base32 + p); acc[ai][bj][m][1] = *(const f32x4*)(base32 + p + 4); }
                    else { const u32x4 r = *(const u32x4*)(xn + p); acc[ai][bj][m][0] = (f32x4){__uint_as_float(r.x << 16), __uint_as_float(r.x & 0xffff0000u), __uint_as_float(r.y << 16), __uint_as_float(r.y & 0xffff0000u)};
                        acc[ai][bj][m][1] = (f32x4){__uint_as_float(r.z << 16), __uint_as_float(r.z & 0xffff0000u), __uint_as_float(r.w << 16), __uint_as_float(r.w & 0xffff0000u)}; }
                    asm volatile("" : "+v"(acc[ai][bj][m][0]), "+v"(acc[ai][bj][m][1]) :: "memory"); } }
    }
    __device__ __forceinline__ void init(f32x4 (&acc)[2][2][4][2], const Unit& u, int wr, int wc, int fr, int fq) const {
        const int col0 = u.pn * BM + wc * 32 + 8 * fq;
#pragma unroll
        for (int ai = 0; ai < 2; ++ai)
#pragma unroll
            for (int m = 0; m < 4; ++m) { const size_t off = (size_t)(u.pm * BM + ai * HALF + wr * 64 + m * 16 + fr) * ldc + col0;
#pragma unroll
                for (int bj = 0; bj < 2; ++bj) { const size_t p = off + bj * HALF;
                    if (base32) { acc[ai][bj][m][0] = *(const f32x4*)(base32 + p); acc[ai][bj][m][1] = *(const f32x4*)(base32 + p + 4); }
                    else { const u32x4 r = *(const u32x4*)(xn + p); acc[ai][bj][m][0] = (f32x4){__uint_as_float(r.x << 16), __uint_as_float(r.x & 0xffff0000u), __uint_as_float(r.y << 16), __uint_as_float(r.y & 0xffff0000u)};
                        acc[ai][bj][m][1] = (f32x4){__uint_as_float(r.z << 16), __uint_as_float(r.z & 0xffff0000u), __uint_as_float(r.w << 16), __uint_as_float(r.w & 0xffff0000u)}; } } }
#pragma unroll
        for (int ai = 0; ai < 2; ++ai)
#pragma unroll
            for (int bj = 0; bj < 2; ++bj)
#pragma unroll
                for (int m = 0; m < 4; ++m) asm volatile("" : "+v"(acc[ai][bj][m][0]), "+v"(acc[ai][bj][m][1]));
    }
    __device__ __forceinline__ void operator()(const f32x4 (&acc)[2][2][4][2], const Unit& u, int wr, int wc, int fr, int fq) const {
        const int col0 = u.pn * BM + wc * 32 + 8 * fq;
#pragma unroll
        for (int ai = 0; ai < 2; ++ai)
#pragma unroll
            for (int m = 0; m < 4; ++m) { const int row = u.pm * BM + ai * HALF + wr * 64 + m * 16 + fr; const size_t off = (size_t)row * ldc + col0; float ss = 0.f;
#pragma unroll
                for (int bj = 0; bj < 2; ++bj) { const size_t p = off + bj * HALF; const f32x4 v0 = acc[ai][bj][m][0], v1 = acc[ai][bj][m][1];
                    ss += ((v0[0] * v0[0] + v0[1] * v0[1]) + (v0[2] * v0[2] + v0[3] * v0[3])) + ((v1[0] * v1[0] + v1[1] * v1[1]) + (v1[2] * v1[2] + v1[3] * v1[3]));
                    if (out32) { *(f32x4*)(out32 + p) = v0; *(f32x4*)(out32 + p + 4) = v1; }
                    if (!out32) { u32x4 w; w.x = cvt_pk_bf16(v0[0], v0[1]); w.y = cvt_pk_bf16(v0[2], v0[3]); w.z = cvt_pk_bf16(v1[0], v1[1]); w.w = cvt_pk_bf16(v1[2], v1[3]);
                    *(u32x4*)(xn + p) = w; } }
                ss = fq_sum(ss);
                if (fq == 0) xl[(ai * HALF + wr * 64 + m * 16 + fr) * 4 + wc] = ss;
                asm volatile("" ::: "memory"); }
        asm volatile("s_waitcnt lgkmcnt(0)" ::: "memory"); __builtin_amdgcn_s_barrier(); asm volatile("" ::: "memory");
        { const int t = (wr * 4 + wc) * 64 + fq * 16 + fr;
          if (t < BM) { const f32x4 q = *(const PG8_LAS f32x4*)(xl + t * 4); xs[(size_t)(u.pm * BM + t) * 4 + u.pn] = (q[0] + q[1]) + (q[2] + q[3]); } }
    }
};

template <class Epi, class Sched, bool ALIGN_EPI = false, bool SP2 = false>
__device__ __forceinline__ void gemm_phase(PG8_LAS unsigned char* lds, const Gemm g, const Sched& S, const Epi& E, const int tid_in) {
    const int tid = tid_in, wid = __builtin_amdgcn_readfirstlane(tid >> 6), lane = tid & 63, wr = wid >> 2, wc = wid & 3, fr = lane & 15, fq = lane >> 4;
    const int K = g.K, nt = K / BK;
    unsigned voffA[2], voffB[2];
#pragma unroll
    for (int i = 0; i < 2; ++i) { int R, C; stage_rc(tid * 16 + i * 8192, R, C); const int Rb = Epi::PERM ? ((R & ~31) + perm32(R & 31)) : R;
        voffA[i] = (unsigned)(R * g.lda + C) * 2u; voffB[i] = (unsigned)(Rb * K + C) * 2u; }
    const size_t kstep = (size_t)(BK * 2);
    const size_t hstepB = (size_t)HALF * K * 2, hstepA = (size_t)HALF * g.lda * 2;
    const size_t tstepB = 2 * hstepB, tstepA = 2 * hstepA;
    const unsigned ldsw = (unsigned)wid * 1024u;
    const int aoff = lds_byte(wr * 64 + fr, fq * 8), boff = lds_byte(wc * 32 + fr, fq * 8);
#define PG8_SA(b, h) (((b) * 2 + (h)) * HTB)
#define PG8_SB(b, h) ((4 + (b) * 2 + (h)) * HTB)
#define PG8_STAGE(bufoff, gbase, voff) do { _Pragma("unroll") for (int _i = 0; _i < 2; ++_i) \
        __builtin_amdgcn_global_load_lds((const unsigned*)((const char*)(gbase) + (voff)[_i]), (PG8_LAS unsigned*)(lds + (bufoff) + ldsw + _i * 8192), 16, 0, 0); } while (0)
#define PG8_LDA(dst, b, h) do { _Pragma("unroll") for (int m = 0; m < 4; ++m) _Pragma("unroll") for (int k = 0; k < 2; ++k) dst[m][k] = *(const PG8_LAS bf16x8*)(lds + PG8_SA(b, h) + aoff + m * 2048 + k * 1024); } while (0)
#define PG8_LDB(dst, b, h) do { _Pragma("unroll") for (int n = 0; n < 2; ++n) _Pragma("unroll") for (int k = 0; k < 2; ++k) dst[n][k] = *(const PG8_LAS bf16x8*)(lds + PG8_SB(b, h) + boff + n * 2048 + k * 1024); } while (0)
#define PG8_MMA(ai, bj, At, Bt) do { __builtin_amdgcn_s_setprio(1); _Pragma("unroll") for (int m = 0; m < 4; ++m) _Pragma("unroll") for (int n = 0; n < 2; ++n) _Pragma("unroll") for (int k = 0; k < 2; ++k) \
        acc[ai][bj][m][n] = __builtin_amdgcn_mfma_f32_16x16x32_bf16(Bt[n][k], At[m][k], acc[ai][bj][m][n], 0, 0, 0); __builtin_amdgcn_s_setprio(0); } while (0)
#define PG8_WAIT_V(n) asm volatile("s_waitcnt vmcnt(" #n ")" ::: "memory")
#define PG8_WAIT_L(n) asm volatile("s_waitcnt lgkmcnt(" #n ")" ::: "memory")
#define PG8_BAR __builtin_amdgcn_s_barrier()
#define PG8_SCHED __builtin_amdgcn_sched_barrier(0)
    Unit cur, nxt; int ui = 0;
    if (!S.next(0, cur)) return;
    f32x4 acc[2][2][4][2];
    if constexpr (Epi::HAS_INIT) { E.init(acc, cur, wr, wc, fr, fq); }
    else {
#pragma unroll
    for (int a = 0; a < 2; ++a)
#pragma unroll
        for (int b = 0; b < 2; ++b)
#pragma unroll
            for (int m = 0; m < 4; ++m)
#pragma unroll
                for (int n = 0; n < 2; ++n) acc[a][b][m][n] = (f32x4){0.f, 0.f, 0.f, 0.f};
    }
    bf16x8 At[4][2], B0[2][2], B1[2][2];
    const char* cA = (const char*)g.A + (size_t)cur.pm * tstepA + (size_t)(cur.pm >> 3) * g.abx; const char* cB = (const char*)g.Bt + (size_t)cur.pn * tstepB;
    S.a_ready(cur);
    if constexpr (SP2) {
        PG8_STAGE(PG8_SB(0, 0), cB, voffB); PG8_STAGE(PG8_SB(0, 1), cB + hstepB, voffB); PG8_STAGE(PG8_SA(0, 0), cA, voffA); PG8_STAGE(PG8_SA(0, 1), cA + hstepA, voffA);
        if (wr == 1) PG8_BAR;
        PG8_WAIT_V(2); PG8_BAR;
        PG8_STAGE(PG8_SB(1, 0), cB + kstep, voffB); PG8_STAGE(PG8_SA(1, 0), cA + kstep, voffA); PG8_STAGE(PG8_SB(1, 1), cB + hstepB + kstep, voffB);
        PG8_WAIT_V(6); PG8_BAR;
    } else {
        PG8_STAGE(PG8_SB(0, 0), cB, voffB); PG8_STAGE(PG8_SA(0, 0), cA, voffA); PG8_STAGE(PG8_SB(0, 1), cB + hstepB, voffB); PG8_STAGE(PG8_SA(0, 1), cA + hstepA, voffA);
        if (wr == 1) PG8_BAR;
        PG8_WAIT_V(4); PG8_BAR;
        PG8_STAGE(PG8_SB(1, 0), cB + kstep, voffB); PG8_STAGE(PG8_SA(1, 0), cA + kstep, voffA); PG8_STAGE(PG8_SB(1, 1), cB + hstepB + kstep, voffB);
        PG8_WAIT_V(6); PG8_BAR;
    }
    if constexpr (Epi::HAS_PRE) E.pre(tid);
    for (;;) {
        const bool has_next = S.next(ui + 1, nxt);
        const char* nA = has_next ? (const char*)g.A + (size_t)nxt.pm * tstepA + (size_t)(nxt.pm >> 3) * g.abx : cA; const char* nB = has_next ? (const char*)g.Bt + (size_t)nxt.pn * tstepB : cB;
        for (int t = 0; t < nt; t += 2) {
            const bool last = (t == nt - 2);
            const char* a1 = cA + (size_t)(t + 1) * kstep;
            const char* a2 = last ? nA : cA + (size_t)(t + 2) * kstep; const char* b2 = last ? nB : cB + (size_t)(t + 2) * kstep;
            const char* a3 = a2 + kstep; const char* b3 = b2 + kstep;
            if (last && has_next) S.a_ready(nxt);
            if constexpr (SP2) {
            PG8_LDB(B0, 0, 0); PG8_LDB(B1, 0, 1); PG8_SCHED; PG8_LDA(At, 0, 0); PG8_STAGE(PG8_SA(1, 1), a1 + hstepA, voffA);
            PG8_WAIT_V(8); PG8_WAIT_L(0); PG8_BAR; PG8_MMA(0, 0, At, B0); PG8_MMA(0, 1, At, B1); PG8_BAR; PG8_SCHED;
            PG8_LDA(At, 0, 1); PG8_STAGE(PG8_SB(0, 0), b2, voffB); PG8_STAGE(PG8_SB(0, 1), b2 + hstepB, voffB); PG8_STAGE(PG8_SA(0, 0), a2, voffA);
            PG8_WAIT_V(8); PG8_WAIT_L(0); PG8_BAR; PG8_MMA(1, 0, At, B0); PG8_MMA(1, 1, At, B1); PG8_BAR; PG8_SCHED;
            PG8_LDB(B0, 1, 0); PG8_LDB(B1, 1, 1); PG8_SCHED; PG8_LDA(At, 1, 0); PG8_STAGE(PG8_SA(0, 1), a2 + hstepA, voffA);
            PG8_WAIT_V(8); PG8_WAIT_L(0); PG8_BAR; PG8_MMA(0, 0, At, B0); PG8_MMA(0, 1, At, B1); PG8_BAR; PG8_SCHED;
            PG8_LDA(At, 1, 1); PG8_STAGE(PG8_SB(1, 0), b3, voffB); PG8_STAGE(PG8_SB(1, 1), b3 + hstepB, voffB); PG8_STAGE(PG8_SA(1, 0), a3, voffA);
            PG8_WAIT_V(8); PG8_WAIT_L(0); PG8_BAR; PG8_MMA(1, 0, At, B0); PG8_MMA(1, 1, At, B1); PG8_BAR; PG8_SCHED;
            } else {
            PG8_LDB(B0, 0, 0); PG8_SCHED; PG8_LDA(At, 0, 0); PG8_STAGE(PG8_SA(1, 1), a1 + hstepA, voffA);
            PG8_WAIT_L(8); PG8_BAR; PG8_WAIT_L(0); PG8_MMA(0, 0, At, B0); PG8_BAR; PG8_SCHED;
            PG8_LDB(B1, 0, 1); PG8_STAGE(PG8_SB(0, 0), b2, voffB);
            PG8_BAR; PG8_WAIT_L(0); PG8_MMA(0, 1, At, B1); PG8_BAR;
            PG8_LDA(At, 0, 1); PG8_STAGE(PG8_SA(0, 0), a2, voffA);
            PG8_BAR; PG8_WAIT_L(0); PG8_MMA(1, 0, At, B0); PG8_BAR; PG8_SCHED;
            PG8_STAGE(PG8_SB(0, 1), b2 + hstepB, voffB);
            PG8_WAIT_V(6); PG8_BAR; PG8_MMA(1, 1, At, B1); PG8_BAR;
            PG8_LDB(B0, 1, 0); PG8_SCHED; PG8_LDA(At, 1, 0); PG8_STAGE(PG8_SA(0, 1), a2 + hstepA, voffA);
            PG8_WAIT_L(8); PG8_BAR; PG8_WAIT_L(0); PG8_MMA(0, 0, At, B0); PG8_BAR; PG8_SCHED;
            PG8_LDB(B1, 1, 1); PG8_STAGE(PG8_SB(1, 0), b3, voffB);
            PG8_BAR; PG8_WAIT_L(0); PG8_MMA(0, 1, At, B1); PG8_BAR;
            PG8_LDA(At, 1, 1); PG8_STAGE(PG8_SA(1, 0), a3, voffA);
            PG8_BAR; PG8_WAIT_L(0); PG8_MMA(1, 0, At, B0); PG8_BAR; PG8_SCHED;
            PG8_STAGE(PG8_SB(1, 1), b3 + hstepB, voffB);
            PG8_WAIT_V(6); PG8_BAR; PG8_MMA(1, 1, At, B1); PG8_BAR;
            }
        }
        if constexpr (ALIGN_EPI) { if (wr == 0) PG8_BAR; }
        if constexpr (!Epi::AFTER_DRAIN) { E(acc, cur, wr, wc, fr, fq); S.done(cur); }
        if (!has_next) break;
        if constexpr (Epi::HAS_INIT) { E.init_slow(acc, nxt, wr, wc, fr, fq); } else
#pragma unroll
        for (int a = 0; a < 2; ++a)
#pragma unroll
            for (int b = 0; b < 2; ++b)
#pragma unroll
                for (int m = 0; m < 4; ++m)
#pragma unroll
                    for (int n = 0; n < 2; ++n) acc[a][b][m][n] = (f32x4){0.f, 0.f, 0.f, 0.f};
        cur = nxt; cA = nA; cB = nB; ++ui;
        if constexpr (ALIGN_EPI) { if (wr == 1) PG8_BAR; }
    }
    PG8_WAIT_V(0);
    if constexpr (!ALIGN_EPI) { if (wr == 0) PG8_BAR; }
    PG8_BAR;
    if constexpr (Epi::AFTER_DRAIN) { E.fused(acc, cur, wr, wc, fr, fq, lds, wid, lane); S.done(cur); }
#undef PG8_SA
#undef PG8_SB
#undef PG8_STAGE
#undef PG8_LDA
#undef PG8_LDB
#undef PG8_MMA
#undef PG8_WAIT_V
#undef PG8_WAIT_L
#undef PG8_BAR
#undef PG8_SCHED
}
}
#include <hip/hip_bf16.h>
#include <cmath>
namespace attn_body {
using bf16=__hip_bfloat16;
using bf16x8=__attribute__((ext_vector_type(8)))short;
using s16x4=__attribute__((ext_vector_type(4)))short;
using f32x16=__attribute__((ext_vector_type(16)))float;
using u32x4=__attribute__((ext_vector_type(4)))unsigned;
constexpr int BATCH=8,NHEAD=16,SEQ=2048,D=64,DM=NHEAD*D;
constexpr int NW=8,QBLK=32,QB=QBLK*NW,KVBLK=64,NQB=SEQ/QB;
constexpr int ATTN_PITCH=DM, ATTN_UNIT_ROWS=QB;
__device__ __forceinline__ int crow(int r,int hi){return (r&3)+8*(r>>2)+4*hi;}
#define SBAR() __builtin_amdgcn_sched_barrier(0)
__device__ __forceinline__ void cmask(f32x16&p0,f32x16&p1,int jb,int qrel,int hi){
  const float NEG=-INFINITY; int kb=64*jb+4*hi;
  #pragma unroll
  for(int r=0;r<16;++r){int kv=kb+(r&3)+8*(r>>2); if(kv>qrel)p0[r]=NEG; if(kv+32>qrel)p1[r]=NEG;}
}

constexpr int NSLOT=3, SLOTB=8192;
constexpr int LDS_K=0, LDS_V=NSLOT*SLOTB, LDS_WS=2*NSLOT*SLOTB, LDS_OST=LDS_WS+NW*64*4, LDS_KB3=LDS_OST+NW*4096, LDS_BYTES=LDS_KB3+SEQ*8;
constexpr float C2=0.125f*1.4426950408889634f;
__device__ __forceinline__ void glds16(const void*gsrc,unsigned lds_dst){unsigned keep;
  asm volatile("s_mov_b32 %0, m0\n\ts_mov_b32 m0, %2\n\ts_nop 0\n\tglobal_load_lds_dwordx4 %1, off\n\ts_mov_b32 m0, %0":"=&s"(keep):"v"(gsrc),"s"(lds_dst):"memory");}
__device__ __forceinline__ float max3f(float a,float b,float c){float r;asm("v_max3_f32 %0, %1, %2, %3":"=v"(r):"v"(a),"v"(b),"v"(c));return r;}
__device__ __forceinline__ float max2f(float a,float b){float r;asm("v_max_f32_e32 %0, %1, %2":"=v"(r):"v"(a),"v"(b));return r;}
__device__ __forceinline__ float fadd_s(float a,float b){float r;asm("v_add_f32_e32 %0, %1, %2":"=v"(r):"v"(a),"v"(b));return r;}
__device__ __forceinline__ float fsub_s(float a,float b){float r;asm("v_sub_f32_e32 %0, %1, %2":"=v"(r):"v"(a),"v"(b));return r;}
typedef unsigned u32x2_t __attribute__((ext_vector_type(2)));
typedef float f32x2_t __attribute__((ext_vector_type(2))); typedef __bf16 bf16x2_t __attribute__((ext_vector_type(2)));
__device__ __forceinline__ unsigned cvtpk_s(float lo,float hi){f32x2_t v={lo,hi};bf16x2_t b=__builtin_convertvector(v,bf16x2_t);return __builtin_bit_cast(unsigned,b);}
#define WAIT_BAR(N) asm volatile("s_waitcnt vmcnt(" #N ") lgkmcnt(0)\n\ts_barrier":::"memory")

__device__ __forceinline__ void qkt(f32x16&p0,f32x16&p1,const char*Kslot,const bf16x8*qr,const f32x16&negm,int r32,int hi,bf16x8 kbA,bf16x8 kbB,bf16x8 ones){
  p0=__builtin_amdgcn_mfma_f32_32x32x16_bf16(kbA,ones,negm,0,0,0);p1=__builtin_amdgcn_mfma_f32_32x32x16_bf16(kbB,ones,negm,0,0,0);
  const char*kb=Kslot+hi*1024+r32*16;
  #pragma unroll
  for(int d0=0;d0<4;++d0){
    const bf16x8 b0=*reinterpret_cast<const bf16x8*>(kb+d0*2048);
    const bf16x8 b1=*reinterpret_cast<const bf16x8*>(kb+d0*2048+512);
    {p0=__builtin_amdgcn_mfma_f32_32x32x16_bf16(b0,qr[d0],p0,0,0,0);p1=__builtin_amdgcn_mfma_f32_32x32x16_bf16(b1,qr[d0],p1,0,0,0);}}
}
typedef __attribute__((address_space(3))) const char* lds_cptr;
typedef short v4i16_t __attribute__((ext_vector_type(4)));
__device__ __forceinline__ void kload8(bf16x8*kf,lds_cptr kp){
  kf[0]=*(const __attribute__((address_space(3))) bf16x8*)(kp);      kf[1]=*(const __attribute__((address_space(3))) bf16x8*)(kp+512);
  kf[2]=*(const __attribute__((address_space(3))) bf16x8*)(kp+2048); kf[3]=*(const __attribute__((address_space(3))) bf16x8*)(kp+2560);
  kf[4]=*(const __attribute__((address_space(3))) bf16x8*)(kp+4096); kf[5]=*(const __attribute__((address_space(3))) bf16x8*)(kp+4608);
  kf[6]=*(const __attribute__((address_space(3))) bf16x8*)(kp+6144); kf[7]=*(const __attribute__((address_space(3))) bf16x8*)(kp+6656);
}
__device__ __forceinline__ void kload2(bf16x8*kf,lds_cptr kp,int j){ kf[2*j]=*(const __attribute__((address_space(3))) bf16x8*)(kp+j*2048); kf[2*j+1]=*(const __attribute__((address_space(3))) bf16x8*)(kp+j*2048+512); }
__device__ __forceinline__ s16x4 vtr(lds_cptr p){ return __builtin_bit_cast(s16x4,__builtin_amdgcn_ds_read_tr16_b64_v4i16((__attribute__((address_space(3))) v4i16_t*)p)); }
__device__ __forceinline__ float rowmax(const f32x16&p0,const f32x16&p1){
  float a=max3f(p0[0],p0[1],p1[0]),b=max3f(p0[2],p0[3],p1[1]);a=max3f(a,p1[2],p1[3]);
  #pragma unroll
  for(int r=4;r<16;r+=4){a=max3f(a,p0[r],p0[r+1]);b=max3f(b,p0[r+2],p0[r+3]);a=max3f(a,p1[r],p1[r+1]);b=max3f(b,p1[r+2],p1[r+3]);}
  const float m=max2f(a,b);
  auto rr=__builtin_amdgcn_permlane32_swap(__float_as_uint(m),__float_as_uint(m),false,false);
  return max2f(__uint_as_float(rr[0]),__uint_as_float(rr[1]));
}
__device__ __forceinline__ void pv(f32x16*o,int vb,bf16x8 pa0,bf16x8 pa1,bf16x8 pa2,bf16x8 pa3){
  #pragma unroll
  for(int d0=0;d0<2;++d0){s16x4 lo[4],hi[4];
    #pragma unroll
    for(int ks=0;ks<4;++ks){
      asm volatile("ds_read_b64_tr_b16 %0,%1 offset:%c2":"=&v"(lo[ks]):"v"(vb),"i"(d0*4096+ks*1024):"memory");
      asm volatile("ds_read_b64_tr_b16 %0,%1 offset:%c2":"=&v"(hi[ks]):"v"(vb),"i"(d0*4096+ks*1024+512):"memory");}
    asm volatile("s_waitcnt lgkmcnt(0)":::"memory");SBAR();
    #define PK(k) (bf16x8){lo[k][0],lo[k][1],lo[k][2],lo[k][3],hi[k][0],hi[k][1],hi[k][2],hi[k][3]}
    o[d0]=__builtin_amdgcn_mfma_f32_32x32x16_bf16(pa0,PK(0),o[d0],0,0,0);
    o[d0]=__builtin_amdgcn_mfma_f32_32x32x16_bf16(pa1,PK(1),o[d0],0,0,0);
    o[d0]=__builtin_amdgcn_mfma_f32_32x32x16_bf16(pa2,PK(2),o[d0],0,0,0);
    o[d0]=__builtin_amdgcn_mfma_f32_32x32x16_bf16(pa3,PK(3),o[d0],0,0,0);
    #undef PK
  }
}

#ifndef ATTN_STORE16
#define ATTN_STORE16(p,v) (*(u32x4*)(p)=(v))
#endif
template<int THRL> __device__ __forceinline__ void attn_unit(int b,int h,int qb,const bf16*Q,const bf16*__restrict__ K,const bf16*__restrict__ V,bf16*O,const bf16*__restrict__ Gt,const float*__restrict__ LOGF,const float qkbound,char*shm,const int tid_in){
  const int tid=tid_in,lane=tid&63,r32=lane&31,hi=lane>>5; const int wid=__builtin_amdgcn_readfirstlane(tid>>6);
  const long rowbase=(long)b*SEQ; const int q0=qb*QB;
  const bf16*Qw=Q+(rowbase+q0+wid*QBLK)*DM+h*D;
  const bf16*Kh=K+rowbase*DM+h*D,*Vh=V+rowbase*DM+h*D;
  const unsigned lds0=(unsigned)(uintptr_t)shm;
  float*wsf=(float*)(shm+LDS_WS)+wid*64;
  const bf16*ksrc0_=Kh+(long)lane*DM+wid*8;
  const bf16*vsrc0_=Vh+(long)(16*(wid&3)+(lane>>2))*DM+(wid>>2)*32+(lane&3)*8;
  const unsigned kdst=lds0+LDS_K+wid*1024, vdst=lds0+LDS_V+wid*1024;
  #define DMA_K(t,slot) glds16(ksrc+(long)(t)*KVBLK*DM,(unsigned)__builtin_amdgcn_readfirstlane(kdst+(slot)))
  #define DMA_V(t,slot) glds16(vsrc+(long)(t)*KVBLK*DM,(unsigned)__builtin_amdgcn_readfirstlane(vdst+(slot)))
  const int vb0=(int)(lds0+LDS_V)+((lane>>4)&1)*32+(lane&3)*8+(4*hi+((lane&15)>>2))*64;
  const char*Kbase=shm+LDS_K; bf16x8 kf[8];
  const lds_cptr shm3=(lds_cptr)shm; const lds_cptr kp0=shm3+LDS_K+hi*1024+r32*16; const lds_cptr vp0=shm3+LDS_V+((lane>>4)&1)*32+(lane&3)*8+(4*hi+((lane&15)>>2))*64;
  const int NT0_=(q0+QB)/KVBLK;
  int t0_=0;
  {
    typedef float f32x4_a __attribute__((ext_vector_type(4))); const int nk=q0+QB; const f32x4_a x4=(4*tid<nk)?*(const f32x4_a*)(LOGF+(long)(b*NHEAD+h)*SEQ+4*tid):(f32x4_a){0.f,0.f,0.f,0.f};
    const float p0_=x4[0],p1_=p0_+x4[1],p2_=p1_+x4[2],p3_=p2_+x4[3]; float incl=p3_;
    #pragma unroll
    for(int off=1;off<64;off<<=1){const float t_=__uint_as_float((unsigned)__builtin_amdgcn_ds_bpermute(4*(lane-off),(int)__float_as_uint(incl))); if(lane>=off)incl+=t_;}
    __attribute__((address_space(3))) float*wsum=(__attribute__((address_space(3))) float*)(shm3+LDS_WS);
    if(lane==63)wsum[wid]=incl;
    asm volatile("s_waitcnt vmcnt(0) lgkmcnt(0)\n\ts_barrier":::"memory");
    float basec=incl-p3_;
    #pragma unroll
    for(int w_=0;w_<NW-1;++w_){const float ws_=wsum[w_]; if(w_<wid)basec+=ws_;}
    if(4*tid<nk){ const float L2E=1.4426950408889634f; unsigned long long e_[4]; const float pc_[4]={p0_,p1_,p2_,p3_};
      #pragma unroll
      for(int k_=0;k_<4;++k_){ const float v_=-(basec+pc_[k_])*L2E; const unsigned h_=__builtin_bit_cast(unsigned,__builtin_bit_cast(unsigned,v_));
        const unsigned hb_=(h_+0x7fffu+((h_>>16)&1u))>>16; const float r1_=v_-__uint_as_float(hb_<<16); const unsigned m1_=__builtin_bit_cast(unsigned,r1_); const unsigned mb_=(m1_+0x7fffu+((m1_>>16)&1u))>>16;
        const float r2_=r1_-__uint_as_float(mb_<<16); const unsigned l1_=__builtin_bit_cast(unsigned,r2_); const unsigned lb_=(l1_+0x7fffu+((l1_>>16)&1u))>>16;
        e_[k_]=(unsigned long long)hb_|((unsigned long long)mb_<<16)|((unsigned long long)lb_<<32)|(0x3F80ull<<48); }
      *(__attribute__((address_space(3))) u32x4*)(shm3+LDS_KB3+32*tid)=(u32x4){(unsigned)e_[0],(unsigned)(e_[0]>>32),(unsigned)e_[1],(unsigned)(e_[1]>>32)};
      *(__attribute__((address_space(3))) u32x4*)(shm3+LDS_KB3+32*tid+16)=(u32x4){(unsigned)e_[2],(unsigned)(e_[2]>>32),(unsigned)e_[3],(unsigned)(e_[3]>>32)};
      int tq_=tid>>4; asm volatile("":"+v"(tq_));
      if((tid&15)==15)wsum[16+tq_]=basec+p3_;
      if(4*tid==q0)wsum[48]=basec+p0_; }
    asm volatile("s_waitcnt lgkmcnt(0)\n\ts_barrier":::"memory");
    { const int j_=lane; const float cj_=wsum[16+(j_&31)], cq_=wsum[48];
      const bool sk_=(j_<NT0_-4)&&((cq_-cj_)*1.4426950408889634f+qkbound<-152.0f);
      const unsigned long long m_=__builtin_amdgcn_ballot_w64(sk_);
      t0_=(int)__builtin_amdgcn_readfirstlane((int)__builtin_ctzll(~m_))&~1; } }
  const int NT=NT0_-t0_; const bf16*ksrc=ksrc0_+(long)t0_*KVBLK*DM; const bf16*vsrc=vsrc0_+(long)t0_*KVBLK*DM;
  const lds_cptr kbl3=shm3+LDS_KB3+t0_*KVBLK*8;
  asm volatile("s_waitcnt vmcnt(0)":::"memory");
  bf16x8 ones;
  #define KBLOAD(t,FA,FB) bf16x8 FA,FB; { const lds_cptr kbp_=kbl3+((t)*KVBLK+r32)*8; \
      u32x2_t wa_=*(const __attribute__((address_space(3))) u32x2_t*)(kbp_), wb_=*(const __attribute__((address_space(3))) u32x2_t*)(kbp_+256); \
      if(hi){wa_=(u32x2_t){0u,0u};wb_=(u32x2_t){0u,0u};} \
      FA=__builtin_bit_cast(bf16x8,(u32x4){wa_[0],wa_[1],hi?0u:0x3F803F80u,0u}); FB=__builtin_bit_cast(bf16x8,(u32x4){wb_[0],wb_[1],hi?0u:0x3F803F80u,0u}); }
  DMA_K(0,0);DMA_V(0,0);DMA_K(1,SLOTB);
  bf16x8 qr[4];
  #pragma unroll
  for(int d0=0;d0<4;++d0)qr[d0]=*reinterpret_cast<const bf16x8*>(&Qw[(long)r32*DM+d0*16+hi*8]);
  float zero_; asm volatile("v_mov_b32 %0, 0":"=v"(zero_));
  float mhat=0.f,l_reg=0.f;f32x16 o[2];f32x16 negm;
  _Pragma("unroll") for(int r=0;r<16;++r){o[0][r]=zero_;o[1][r]=zero_;negm[r]=zero_;} asm volatile("":"+v"(negm));
  const int qrel=wid*QBLK+r32;
  #define CMASK(P0,P1,t) do{int jb_=(t)-(NT-4); if(jb_>=0)cmask(P0,P1,jb_,qrel,hi);}while(0)
  bool resc=false;
  #define START(P0,P1) do{ const float rm=rowmax(P0,P1); resc=false; \
    { const float dl=__builtin_fmaxf(rm,0.f); mhat=fadd_s(mhat,dl);     \
      _Pragma("unroll") for(int r=0;r<16;++r){P0[r]=fsub_s(P0[r],dl);P1[r]=fsub_s(P1[r],dl);} \
      _Pragma("unroll") for(int r=0;r<16;++r)negm[r]=-mhat; asm volatile("":"+v"(negm)); } \
    _Pragma("unroll") for(int r=0;r<16;++r)P0[r]=__builtin_amdgcn_exp2f(P0[r]); }while(0)
  #define RESC() do{ if(resc){ asm volatile("s_waitcnt lgkmcnt(0)":::"memory"); \
      _Pragma("unroll") for(int d_=0;d_<2;++d_) _Pragma("unroll") for(int r=0;r<16;++r)o[d_][r]*=wsf[crow(r,hi)]; } }while(0)
  f32x16 pA0,pA1,pB0,pB1;
  int sl_prev=0,sl_cur=0,sl_next=SLOTB;
  #define ROT() do{sl_prev=sl_cur;sl_cur=sl_next;sl_next=(sl_next==(NSLOT-1)*SLOTB)?0:sl_next+SLOTB;}while(0)
  DMA_K(2,2*SLOTB);
  WAIT_BAR(3);
  { const u32x2_t wq_=*(const __attribute__((address_space(3))) u32x2_t*)(shm3+LDS_KB3+(q0+wid*QBLK+r32)*8);
    ones=__builtin_bit_cast(bf16x8,(u32x4){hi?0u:0x3F803F80u, hi?0u:(0x3F80u|(((wq_[0]&0xffffu)^0x8000u)<<16)), hi?0u:(((wq_[0]>>16)^0x8000u)|(((wq_[1]&0xffffu)^0x8000u)<<16)), 0u}); }
  { KBLOAD(0,kbA0_,kbB0_); qkt(pA0,pA1,Kbase,qr,negm,r32,hi,kbA0_,kbB0_,ones); } asm volatile("s_nop 15\n\ts_nop 7":"+v"(pA0),"+v"(pA1));CMASK(pA0,pA1,0);
  START(pA0,pA1);
  _Pragma("unroll") for(int r=0;r<16;++r)pA1[r]=__builtin_amdgcn_exp2f(pA1[r]);
  WAIT_BAR(0);
  DMA_K(3,0);DMA_V(1,SLOTB);
  ROT();
  kload8(kf,kp0+sl_cur);
  WAIT_BAR(2);
  s16x4 vlo[8],vhi[8]; u32x4 pw0,pw1,pw2,pw3;
  #define PKW(P,B) cvtpk_s(P[B],P[B+1])
  #define PAF(k) __builtin_bit_cast(bf16x8,pw##k)
  #define VFR(i) (bf16x8){vlo[i][0],vlo[i][1],vlo[i][2],vlo[i][3],vhi[i][0],vhi[i][1],vhi[i][2],vhi[i][3]}
  #define PIN(x) asm volatile("":"+v"(x))
  #define MX3(a,b,c) __builtin_fmaxf(__builtin_fmaxf((a),(b)),(c))
  #define GAPA(MF,A0,A1,A2,A3,W0,W1,PW) do{ MF; sacc+=A0; sacc+=A1; sacc+=A2; sacc+=A3; PIN(sacc); W0; W1; PIN(PW); SBAR(); }while(0)
  #define EX(v) __builtin_amdgcn_exp2f(v)
  #define GAPB(MF,X,B) do{ MF; X[B]=EX(X[B]); X[B+1]=EX(X[B+1]); X[B+2]=EX(X[B+2]); X[B+3]=EX(X[B+3]); PIN(X); SBAR(); }while(0)
  #define VRD(i) do{ vlo[i]=vtr(vp_+(((i)>>2)*4096+((i)&3)*1024)); vhi[i]=vtr(vp_+(((i)>>2)*4096+((i)&3)*1024+512)); }while(0)
  #define KRD(G,j) do{ if(G){ kload2(kf,kp0+sl_next,j); SBAR(); } }while(0)
  #define STEP(C0,C1,P0,P1,t,GK,GV,GL) do{ SBAR(); \
    { KBLOAD(t,kbA_,kbB_); C0=__builtin_amdgcn_mfma_f32_32x32x16_bf16(kbA_,ones,negm,0,0,0); C1=__builtin_amdgcn_mfma_f32_32x32x16_bf16(kbB_,ones,negm,0,0,0); } SBAR(); \
    const lds_cptr vp_=vp0+sl_prev; \
    VRD(0); SBAR(); float sacc=(P0[0]+P0[1]); \
    GAPA(C0=__builtin_amdgcn_mfma_f32_32x32x16_bf16(kf[0],qr[0],C0,0,0,0), P0[2],P0[3],P0[4],P0[5],     pw0[0]=PKW(P0,0), pw0[1]=PKW(P0,2), pw0); \
    VRD(4); SBAR(); GAPA(C1=__builtin_amdgcn_mfma_f32_32x32x16_bf16(kf[1],qr[0],C1,0,0,0), P0[6],P0[7],P0[8],P0[9],     pw0[2]=PKW(P0,4), pw0[3]=PKW(P0,6), pw0); \
    VRD(1); SBAR(); GAPA(C0=__builtin_amdgcn_mfma_f32_32x32x16_bf16(kf[2],qr[1],C0,0,0,0),   P0[10],P0[11],P0[12],P0[13], pw1[0]=PKW(P0,8), pw1[1]=PKW(P0,10), pw1); \
    VRD(5); SBAR(); GAPA(C1=__builtin_amdgcn_mfma_f32_32x32x16_bf16(kf[3],qr[1],C1,0,0,0),   P0[14],P0[15],P1[0],P1[1],   pw1[2]=PKW(P0,12),pw1[3]=PKW(P0,14), pw1); \
    VRD(2); SBAR(); GAPA(C0=__builtin_amdgcn_mfma_f32_32x32x16_bf16(kf[4],qr[2],C0,0,0,0),   P1[2],P1[3],P1[4],P1[5],     pw2[0]=PKW(P1,0), pw2[1]=PKW(P1,2), pw2); \
    VRD(6); SBAR(); GAPA(C1=__builtin_amdgcn_mfma_f32_32x32x16_bf16(kf[5],qr[2],C1,0,0,0),   P1[6],P1[7],P1[8],P1[9],     pw2[2]=PKW(P1,4), pw2[3]=PKW(P1,6), pw2); \
    VRD(3); SBAR(); GAPA(C0=__builtin_amdgcn_mfma_f32_32x32x16_bf16(kf[6],qr[3],C0,0,0,0),   P1[10],P1[11],P1[12],P1[13], pw3[0]=PKW(P1,8), pw3[1]=PKW(P1,10), pw3); \
    VRD(7); SBAR(); GAPA(C1=__builtin_amdgcn_mfma_f32_32x32x16_bf16(kf[7],qr[3],C1,0,0,0),   P1[14],P1[15],0.f,0.f,       pw3[2]=PKW(P1,12),pw3[3]=PKW(P1,14), pw3); \
    l_reg+=sacc; \
    if(GK){DMA_K((t)+3,sl_cur);} if(GV){DMA_V((t)+1,sl_next);} \
    CMASK(C0,C1,t); \
    { float a=MX3(C0[0],C0[1],C1[0]),b=MX3(C0[2],C0[3],C1[1]); a=MX3(a,C1[2],C1[3]); \
      _Pragma("unroll") for(int r=4;r<16;r+=4){a=MX3(a,C0[r],C0[r+1]);b=MX3(b,C0[r+2],C0[r+3]);a=MX3(a,C1[r],C1[r+1]);b=MX3(b,C1[r+2],C1[r+3]);} \
      float rm=__builtin_fmaxf(a,b); { auto rr=__builtin_amdgcn_permlane32_swap(__float_as_uint(rm),__float_as_uint(rm),false,false); rm=__builtin_fmaxf(__uint_as_float(rr[0]),__uint_as_float(rr[1])); } \
      resc=false; \
      if(__builtin_expect(__any(rm>(float)THRL),0)){ const float dl=__builtin_fmaxf(rm,0.f); mhat+=dl; \
        _Pragma("unroll") for(int r=0;r<16;++r){C0[r]-=dl;C1[r]-=dl;} \
        _Pragma("unroll") for(int r=0;r<16;++r)negm[r]=-mhat; asm volatile("":"+v"(negm)); \
        const float f=__builtin_amdgcn_exp2f(-dl); l_reg*=f; if(hi==0)wsf[r32]=f; resc=true; } } \
    SBAR(); \
    GAPB(o[0]=__builtin_amdgcn_mfma_f32_32x32x16_bf16(PAF(0),VFR(0),o[0],0,0,0), C0,0); \
    GAPB(o[1]=__builtin_amdgcn_mfma_f32_32x32x16_bf16(PAF(0),VFR(4),o[1],0,0,0), C0,4); \
    KRD(GL,0); GAPB(o[0]=__builtin_amdgcn_mfma_f32_32x32x16_bf16(PAF(1),VFR(1),o[0],0,0,0), C0,8); \
    KRD(GL,1); GAPB(o[1]=__builtin_amdgcn_mfma_f32_32x32x16_bf16(PAF(1),VFR(5),o[1],0,0,0), C0,12); \
    KRD(GL,2); GAPB(o[0]=__builtin_amdgcn_mfma_f32_32x32x16_bf16(PAF(2),VFR(2),o[0],0,0,0), C1,0); \
    KRD(GL,3); GAPB(o[1]=__builtin_amdgcn_mfma_f32_32x32x16_bf16(PAF(2),VFR(6),o[1],0,0,0), C1,4); \
    GAPB(o[0]=__builtin_amdgcn_mfma_f32_32x32x16_bf16(PAF(3),VFR(3),o[0],0,0,0), C1,8); \
    GAPB(o[1]=__builtin_amdgcn_mfma_f32_32x32x16_bf16(PAF(3),VFR(7),o[1],0,0,0), C1,12); \
    }while(0)
  int t=1;
  #undef CMASK
  #define CMASK(P0,P1,t) do{}while(0)
  for(;t+5<NT;t+=2){
    STEP(pB0,pB1,pA0,pA1,t,true,true,true);     WAIT_BAR(2); RESC(); ROT();
    STEP(pA0,pA1,pB0,pB1,t+1,true,true,true);   WAIT_BAR(2); RESC(); ROT();
  }
  #undef CMASK
  #define CMASK(P0,P1,t) do{int jb_=(t)-(NT-4); if(jb_>=0)cmask(P0,P1,jb_,qrel,hi);}while(0)
  #define ENDW(tt) do{ if((tt)+3<NT){WAIT_BAR(2);} else if((tt)+2<NT){WAIT_BAR(1);} else {WAIT_BAR(0);} }while(0)
  for(;t+1<NT;t+=2){
    STEP(pB0,pB1,pA0,pA1,t,(t+3<NT),(t+1<NT),(t+1<NT));       ENDW(t);   RESC(); ROT();
    STEP(pA0,pA1,pB0,pB1,t+1,(t+4<NT),(t+2<NT),(t+2<NT));     ENDW(t+1); RESC(); ROT();
  }
  STEP(pB0,pB1,pA0,pA1,NT-1,false,false,false); RESC();
  { float sacc=pB0[0]+pB0[1]; _Pragma("unroll") for(int r=2;r<16;++r)sacc+=pB0[r]; _Pragma("unroll") for(int r=0;r<16;++r)sacc+=pB1[r]; l_reg+=sacc;
    pw0=(u32x4){PKW(pB0,0),PKW(pB0,2),PKW(pB0,4),PKW(pB0,6)};pw1=(u32x4){PKW(pB0,8),PKW(pB0,10),PKW(pB0,12),PKW(pB0,14)};pw2=(u32x4){PKW(pB1,0),PKW(pB1,2),PKW(pB1,4),PKW(pB1,6)};pw3=(u32x4){PKW(pB1,8),PKW(pB1,10),PKW(pB1,12),PKW(pB1,14)};
    SBAR(); pv(o,vb0+sl_cur,PAF(0),PAF(1),PAF(2),PAF(3)); }
  #undef PKW
  #undef PAF
  #undef VFR
  #undef PIN
  #undef MX3
  #undef GAPA
  #undef GAPB
  #undef EX
  #undef VRD
  #undef KRD
  #undef STEP
  #undef ENDW
  {auto rr=__builtin_amdgcn_permlane32_swap(__float_as_uint(l_reg),__float_as_uint(l_reg),false,false);l_reg=__uint_as_float(rr[0])+__uint_as_float(rr[1]);}
  if(hi==0)wsf[32+r32]=l_reg;asm volatile("s_waitcnt lgkmcnt(0)":::"memory");
  float rli[16];
  #pragma unroll
  for(int r=0;r<16;++r)rli[r]=__builtin_amdgcn_rcpf(wsf[32+crow(r,hi)]);
  bf16*Ow=O+(rowbase+q0+wid*QBLK)*DM+h*D; const bf16*Gw=Gt+(rowbase+q0+wid*QBLK)*DM+h*D;
  u32x4 gv[4];
  #pragma unroll
  for(int i=0;i<4;++i){const int row=i*8+(lane>>3),ch=lane&7; gv[i]=*(const u32x4*)(Gw+(long)row*DM+ch*8);}
  { bf16*stg=(bf16*)(shm+LDS_OST)+wid*2048;
    #pragma unroll
    for(int r=0;r<16;++r){const int orow=crow(r,hi);
      #pragma unroll
      for(int d0=0;d0<2;++d0)stg[orow*64+d0*32+r32]=__float2bfloat16(o[d0][r]*rli[r]);}
    asm volatile("s_waitcnt lgkmcnt(0)":::"memory");
    #pragma unroll
    for(int i=0;i<4;++i){const int row=i*8+(lane>>3),ch=lane&7; u32x4 v=*(const u32x4*)(stg+row*64+ch*8);
      #pragma unroll
      for(int w=0;w<4;++w){ const float olo=__uint_as_float(v[w]<<16), ohi=__uint_as_float(v[w]&0xffff0000u), glo=__uint_as_float(gv[i][w]<<16), ghi=__uint_as_float(gv[i][w]&0xffff0000u);
        const float slo=__builtin_amdgcn_rcpf(1.0f+__builtin_amdgcn_exp2f(-1.4426950408889634f*glo)), shi=__builtin_amdgcn_rcpf(1.0f+__builtin_amdgcn_exp2f(-1.4426950408889634f*ghi));
        v[w]=cvtpk_s(olo*slo,ohi*shi); }
      ATTN_STORE16(Ow+(long)row*DM+ch*8,v);} }
  asm volatile("s_waitcnt lgkmcnt(0)\n\ts_barrier":::"memory");
  #undef KBLOAD
  #undef DMA_K
  #undef DMA_V
  #undef CMASK
  #undef START
  #undef RESC
  #undef ROT
}
constexpr int ATTN_LDS_BYTES=LDS_BYTES;
struct AttnTensors { const bf16* Q; const bf16* K; const bf16* V; bf16* O; const bf16* G; const float* LOGF; float qkbound; };
struct AttnUnit { int bh; int qb; };
struct StaticOrder {
  int vcu, grid;
  __device__ __forceinline__ explicit StaticOrder(int grid_,int vcu_):vcu(vcu_),grid(grid_){}
  __device__ __forceinline__ bool next(int i,AttnUnit&u)const{ const int p=vcu+(i>>1)*grid; if(p>=BATCH*NHEAD*4)return false; const int q=(p&31)+32*(p>>8), s=(q<32)?(q&3):(3-(q&3)); u.bh=((p>>5)&7)*NHEAD+((q<32)?(q>>2):(NHEAD-1-((q-32)>>2)));     u.qb=(i&1)?(NQB-1-s):s; return true; }
  __device__ __forceinline__ void a_ready(const AttnUnit&)const{}
  __device__ __forceinline__ void done(const AttnUnit&)const{}
};
template<class Sched,int THRL=8> __device__ __forceinline__ void attn_phase(char*lds,const AttnTensors&T,const Sched&S,const int tid_in){
  AttnUnit u;
  for(int i=0;S.next(i,u);++i){ S.a_ready(u); { const long bo_=(long)(u.bh/NHEAD)*3*SEQ*DM;     attn_unit<THRL>(u.bh/NHEAD,u.bh%NHEAD,u.qb,T.Q+bo_,T.K+bo_,T.V+bo_,T.O+bo_,T.G+bo_,T.LOGF,T.qkbound,lds,tid_in); } S.done(u); }
}
#undef SBAR
#undef WAIT_BAR
}
namespace cg = cooperative_groups;
constexpr int NWAVES = 8;
constexpr int BATCH = 8, SEQ = 2048, D = 1024, M = BATCH * SEQ, FF = 4096, GE = 2048, FOXN = 4112, NPHASES = 21;
constexpr float RMS_EPS = 1e-6f, LN_EPS = 1e-5f;
constexpr size_t MiB = 1u << 20;
constexpr size_t WS_CTL = 0, WS_STATS = 1 * MiB  , WS_LOGF = 6 * MiB  ;
constexpr size_t WS_WF = 512 * 1024  , WS_XS = 5 * MiB  ;
constexpr size_t WS_WIN_G = 8 * MiB, WS_WOUT_G = 24 * MiB, WS_WIN_F = 32 * MiB, WS_WOUT_F = 48 * MiB, WS_W1 = 52 * MiB, WS_W2 = 84 * MiB;
constexpr size_t WS_XN = 116 * MiB, WS_BIG = 148 * MiB, WS_END = 276 * MiB;
constexpr int LDS_BYTES = 147456;
static_assert(attn_body::ATTN_LDS_BYTES <= 131072, "attention LDS");
#define LAS __attribute__((address_space(3)))
typedef unsigned short bf16;
typedef unsigned v4u __attribute__((ext_vector_type(4)));
typedef unsigned v2u __attribute__((ext_vector_type(2)));
typedef float f32x4 __attribute__((ext_vector_type(4)));
typedef short bf16x8 __attribute__((ext_vector_type(8)));
__device__ __forceinline__ unsigned f2bf(float f) { unsigned u = __builtin_bit_cast(unsigned, f); return (u + 0x7fffu + ((u >> 16) & 1u)) >> 16; }
__device__ __forceinline__ unsigned pk2(float lo, float hi) { return f2bf(lo) | (f2bf(hi) << 16); }
__device__ __forceinline__ float bflo(unsigned w) { return __uint_as_float(w << 16); }
__device__ __forceinline__ float bfhi(unsigned w) { return __uint_as_float(w & 0xffff0000u); }
__device__ __forceinline__ float wave_sum(float v) {
#pragma unroll
    for (int o = 1; o < 64; o <<= 1) v += __shfl_xor(v, o);
    return v;
}
typedef __attribute__((address_space(4))) const unsigned char* kptr_t;
struct Frame { LAS unsigned char* lds; int tid, lane, wave, vcu, cid, G; kptr_t kp; };
#define KIN(F_, i) (*(const float* const __attribute__((address_space(4)))*)((F_).kp + 8 * (i)))
#define KOUT(F_) (*(float* const __attribute__((address_space(4)))*)((F_).kp + 128))
#define KWS(F_) (*(unsigned char* const __attribute__((address_space(4)))*)((F_).kp + 136))
__device__ __forceinline__ bool relaunder(Frame& F) { int m1 = -1; asm volatile("" : "+s"(m1)); const int ln = __builtin_amdgcn_mbcnt_hi(m1, __builtin_amdgcn_mbcnt_lo(m1, 0));
    { kptr_t k = F.kp; asm volatile("" : "+s"(k)); F.kp = k; } F.lane = ln; F.tid = F.wave * 64 + ln; return true; }

struct P0Item { const float* W; bf16* WT; const float* gain; int ldw, K, N, item; };
__device__ __forceinline__ P0Item p0_decode(const Frame& F, unsigned char* ws, int it) {
    constexpr int I_WIN = (D / 64) * (4096 / 32), I_WOG = (GE / 64) * (D / 32), I_WOF = (D / 64) * (D / 32), I_W2 = (FF / 64) * (D / 32);
    P0Item q; int r = it;
    constexpr int PER_J = I_WIN + I_WOG + I_WIN + I_WOF;
    if (r < 2 * PER_J) { const int j = r / PER_J; r -= j * PER_J;
        if (r < I_WIN) { q = P0Item{KIN(F, 1) + (size_t)j * D * 4096, (bf16*)(ws + WS_WIN_G + j * 8 * MiB), KIN(F, 12) + (2 * j) * D, 4096, D, 4096, r}; return q; } r -= I_WIN;
        if (r < I_WOG) { q = P0Item{KIN(F, 6) + (size_t)j * GE * D, (bf16*)(ws + WS_WOUT_G + j * 4 * MiB), nullptr, D, GE, D, r}; return q; } r -= I_WOG;
        if (r < I_WIN) { q = P0Item{KIN(F, 7) + (size_t)j * D * FOXN, (bf16*)(ws + WS_WIN_F + j * 8 * MiB), KIN(F, 12) + (2 * j + 1) * D, FOXN, D, 4096, r}; return q; } r -= I_WIN;
        q = P0Item{KIN(F, 11) + (size_t)j * D * D, (bf16*)(ws + WS_WOUT_F + j * 2 * MiB), nullptr, D, D, D, r}; return q; }
    r -= 2 * PER_J; { const int i = r / (I_WIN + I_W2); r -= i * (I_WIN + I_W2);
        if (r < I_WIN) { q = P0Item{KIN(F, 14) + (size_t)i * D * FF, (bf16*)(ws + WS_W1 + i * 8 * MiB), KIN(F, 13) + i * D, FF, D, FF, r}; return q; } r -= I_WIN;
        q = P0Item{KIN(F, 15) + (size_t)i * FF * D, (bf16*)(ws + WS_W2 + i * 8 * MiB), nullptr, D, FF, D, r}; return q; }
}
__device__ __forceinline__ void p0_load(const P0Item& q, int lane, f32x4 (&v)[8]) {
    const int nblk = q.N / 32, kb = q.item / nblk, nb = q.item % nblk, k0 = 64 * kb, n0 = 32 * nb, c = lane & 7, n4 = lane >> 3;
    const float* src = q.W + (size_t)(k0 + 8 * c) * q.ldw + n0 + 4 * n4;
#pragma unroll
    for (int i = 0; i < 8; ++i) v[i] = __builtin_nontemporal_load((const f32x4*)(src + (size_t)i * q.ldw));
}
__device__ __forceinline__ void p0_store(const P0Item& q, int lane, f32x4 (&v)[8]) {
    const int nblk = q.N / 32, kb = q.item / nblk, nb = q.item % nblk, k0 = 64 * kb, n0 = 32 * nb, c = lane & 7, n4 = lane >> 3;
    if (q.gain) { const f32x4 g0 = *(const f32x4*)(q.gain + k0 + 8 * c), g1 = *(const f32x4*)(q.gain + k0 + 8 * c + 4);
        v[0] = v[0] * g0.x; v[1] = v[1] * g0.y; v[2] = v[2] * g0.z; v[3] = v[3] * g0.w; v[4] = v[4] * g1.x; v[5] = v[5] * g1.y; v[6] = v[6] * g1.z; v[7] = v[7] * g1.w; }
#pragma unroll
    for (int e = 0; e < 4; ++e) { v4u o; o.x = pk2(v[0][e], v[1][e]); o.y = pk2(v[2][e], v[3][e]); o.z = pk2(v[4][e], v[5][e]); o.w = pk2(v[6][e], v[7][e]);
        __builtin_nontemporal_store(o, (v4u*)(q.WT + (size_t)(n0 + 4 * n4 + e) * q.K + k0 + 8 * c)); }
}
__device__ __forceinline__ void p0_prologue(const Frame& F, unsigned char* ws) {
    const int gw = F.vcu * NWAVES + F.wave, NGW = F.G * NWAVES;
    constexpr int I_WIN = (D / 64) * (4096 / 32), I_WOG = (GE / 64) * (D / 32), I_WOF = (D / 64) * (D / 32), I_W2 = (FF / 64) * (D / 32);
    constexpr int NITEMS = 2 * (I_WIN + I_WOG + I_WIN + I_WOF) + 4 * (I_WIN + I_W2);
    for (int it = gw; it < NITEMS; it += 4 * NGW) {
        const bool h1 = it + NGW < NITEMS, h2 = it + 2 * NGW < NITEMS, h3 = it + 3 * NGW < NITEMS;
        const P0Item a = p0_decode(F, ws, it), b = p0_decode(F, ws, h1 ? it + NGW : it), c = p0_decode(F, ws, h2 ? it + 2 * NGW : it), d = p0_decode(F, ws, h3 ? it + 3 * NGW : it);
        f32x4 va[8], vb[8], vc[8], vd[8]; p0_load(a, F.lane, va); p0_load(b, F.lane, vb); p0_load(c, F.lane, vc); p0_load(d, F.lane, vd);
        p0_store(a, F.lane, va); if (h1) p0_store(b, F.lane, vb); if (h2) p0_store(c, F.lane, vc); if (h3) p0_store(d, F.lane, vd);
    }
}
__device__ __forceinline__ void p0_rows(const Frame& F, unsigned char* ws) {
    const int gw = F.vcu * NWAVES + F.wave, NGW = F.G * NWAVES;
    bf16* XN = (bf16*)(ws + WS_XN); float* xs = (float*)(ws + WS_XS);
    for (int m = gw; m < M; m += 2 * NGW) {
        const int m2 = (m + NGW < M) ? m + NGW : m;
        const f32x4* xa = (const f32x4*)(KIN(F, 0) + (size_t)m * D) + F.lane; const f32x4* xb = (const f32x4*)(KIN(F, 0) + (size_t)m2 * D) + F.lane;
        f32x4 v[4], w[4]; float sa = 0.f, sb = 0.f;
#pragma unroll
        for (int j = 0; j < 4; ++j) { v[j] = __builtin_nontemporal_load(xa + 64 * j); w[j] = __builtin_nontemporal_load(xb + 64 * j); }
#pragma unroll
        for (int j = 0; j < 4; ++j) { sa += (v[j].x * v[j].x + v[j].y * v[j].y) + (v[j].z * v[j].z + v[j].w * v[j].w); sb += (w[j].x * w[j].x + w[j].y * w[j].y) + (w[j].z * w[j].z + w[j].w * w[j].w); }
        sa = wave_sum(sa); sb = wave_sum(sb);
        unsigned long long* oa = (unsigned long long*)(XN + (size_t)m * D) + F.lane; unsigned long long* ob = (unsigned long long*)(XN + (size_t)m2 * D) + F.lane;
#pragma unroll
        for (int j = 0; j < 4; ++j) { oa[64 * j] = (unsigned long long)pk2(v[j].x, v[j].y) | ((unsigned long long)pk2(v[j].z, v[j].w) << 32); ob[64 * j] = (unsigned long long)pk2(w[j].x, w[j].y) | ((unsigned long long)pk2(w[j].z, w[j].w) << 32); }
        if (F.lane == 0) { *(f32x4*)(xs + (size_t)m * 4) = (f32x4){sa, 0.f, 0.f, 0.f}; *(f32x4*)(xs + (size_t)m2 * 4) = (f32x4){sb, 0.f, 0.f, 0.f}; }
    }
    for (int i = blockIdx.x * (NWAVES * 64) + F.tid; i < 2 * 16 * 1024; i += F.G * NWAVES * 64) { const int j = i >> 14, h = (i >> 10) & 15, k = i & 1023;
        ((bf16*)(ws + WS_WF))[i] = (bf16)f2bf(KIN(F, 7)[(size_t)j * D * FOXN + (size_t)k * FOXN + 4096 + h] * KIN(F, 12)[(2 * j + 1) * D + k]); }
}
__device__ __forceinline__ f32x4 load_rs(const Frame& F, const float* xs, int pm) {
    f32x4 a = (f32x4){1.f, 0.f, 0.f, 0.f};
    if (F.tid < 256 && pm >= 0) a = *(const f32x4*)(xs + ((size_t)pm * 256 + F.tid) * 4);
    return a;
}
__device__ __forceinline__ float qk_bound(const Frame& F, const float* qg, const float* kg) {
    float a = fabsf(qg[F.lane]), b = fabsf(kg[F.lane]);
#pragma unroll
    for (int off = 1; off < 64; off <<= 1) { a = fmaxf(a, __uint_as_float((unsigned)__builtin_amdgcn_ds_bpermute(4 * (F.lane ^ off), (int)__float_as_uint(a)))); b = fmaxf(b, __uint_as_float((unsigned)__builtin_amdgcn_ds_bpermute(4 * (F.lane ^ off), (int)__float_as_uint(b)))); }
    return __uint_as_float((unsigned)__builtin_amdgcn_readfirstlane((int)__float_as_uint(64.0f * a * b * attn_body::C2 * 1.02f + 1.0f)));
}
__device__ __forceinline__ void flogit_prestep(const Frame& F, const bf16* XN, const bf16* WF, const float* xs, const float* bfv, float* logf) {
    const int gw = F.vcu * NWAVES + F.wave, NGW = F.G * NWAVES, fr = F.lane & 15, fq = F.lane >> 4;
    for (int task = F.vcu + F.G * F.wave; task < M / 16; task += NGW) { const int r0 = 16 * (128 * ((task >> 5) & 7) + (task & 31) + 32 * (task >> 8));
        const bf16* ap = XN + (size_t)(r0 + fr) * D + 8 * fq; const bf16* bp = WF + (size_t)fr * D + 8 * fq;
        f32x4 acc = (f32x4){0.f, 0.f, 0.f, 0.f};
#pragma unroll 8
        for (int ks = 0; ks < 32; ++ks) { const bf16x8 a = *(const bf16x8*)(ap + 32 * ks), b = *(const bf16x8*)(bp + 32 * ks); acc = __builtin_amdgcn_mfma_f32_16x16x32_bf16(a, b, acc, 0, 0, 0); }
        const float bh = bfv[fr]; f32x4 lf;
#pragma unroll
        for (int e = 0; e < 4; ++e) { const f32x4 a = *(const f32x4*)(xs + (size_t)(r0 + 4 * fq + e) * 4);
            const float tot = (a[0] + a[1]) + (a[2] + a[3]);
            const float z = acc[e] / sqrtf(tot * (1.0f / D) + RMS_EPS) + bh; lf[e] = fminf(z, 0.f) - 0.6931471805599453f * __builtin_amdgcn_logf(1.0f + __builtin_amdgcn_exp2f(-1.4426950408889634f * fabsf(z))); }
        const int row = r0 + 4 * fq;
        *(f32x4*)(logf + ((size_t)((row >> 11) * 16 + fr)) * SEQ + (row & (SEQ - 1))) = lf;
    }
}
__device__ __forceinline__ void spatial_phase(const Frame& F, bf16* Z, const float* stats, const float* lng, const float* lnb, const float* ws, const float* bs, bool do_store = true) {
    constexpr int LST = 272;
    LAS unsigned char* Wl = F.lds; LAS unsigned char* Vt = F.lds + 128 * LST; LAS float* st = (LAS float*)(F.lds + 128 * LST + 256 * LST);
    const int tid = F.tid, lane = F.lane, w = F.wave, fr = lane & 15, fq = lane >> 4;
    int staged_g = -1;
    for (int unit = F.vcu; unit < (M / 128) * 8; unit += F.G) {
        const int g = unit & 7, chunk = 16 * ((unit >> 5) & 7) + ((unit & 31) >> 3) + 4 * (unit >> 8); const size_t row0 = (size_t)chunk * 128;
        f32x4 sq[16];
        if (tid < 128) { const f32x4* sp = (const f32x4*)(stats + (row0 + tid) * 64);
#pragma unroll
            for (int i = 0; i < 16; ++i) sq[i] = sp[i]; }
        const bf16* va = Z + (row0 + 2 * lane) * 4096 + 2048 + 256 * g + 32 * w;
        v4u rawA[4], rawB[4];
#pragma unroll
        for (int it = 0; it < 4; ++it) { rawA[it] = *(const v4u*)(va + 8 * it); rawB[it] = *(const v4u*)(va + 4096 + 8 * it); }
        v2u uu[8][2];
#pragma unroll
        for (int m = 0; m < 8; ++m)
#pragma unroll
            for (int n = 0; n < 2; ++n) uu[m][n] = *(const v2u*)(Z + (row0 + 16 * m + fr) * 4096 + 256 * g + 32 * w + 16 * n + 4 * fq);
        if (tid < 128) { float s1 = 0.f, s2 = 0.f;
#pragma unroll
            for (int i = 0; i < 16; ++i) { const f32x4 q = sq[i]; s1 += q.x + q.z; s2 += q.y + q.w; }
            const float mean = s1 * (1.0f / GE); const float var = fmaxf(s2 * (1.0f / GE) - mean * mean, 0.f);
            st[2 * tid] = mean; st[2 * tid + 1] = 1.0f / sqrtf(var + LN_EPS); }
        if (g != staged_g) { staged_g = g; const float* wg = ws + (size_t)g * 128 * 128;
#pragma unroll
            for (int i = 0; i < 8; ++i) { const int p = tid + 512 * i, t = p >> 5, s4 = (p & 31) * 4; f32x4 x = *(const f32x4*)(wg + t * 128 + s4);
                if (s4 + 0 > t) x.x = 0.f; if (s4 + 1 > t) x.y = 0.f; if (s4 + 2 > t) x.z = 0.f; if (s4 + 3 > t) x.w = 0.f;
                *(LAS v2u*)(Wl + t * LST + s4 * 2) = (v2u){pk2(x.x, x.y), pk2(x.z, x.w)}; } }
        __syncthreads();
        {
            const float meanA = st[4 * lane], rstdA = st[4 * lane + 1], meanB = st[4 * lane + 2], rstdB = st[4 * lane + 3];
#pragma unroll
            for (int it = 0; it < 4; ++it) { const int c0 = 32 * w + 8 * it;
                const f32x4 ga = *(const f32x4*)(lng + 256 * g + c0), gb = *(const f32x4*)(lng + 256 * g + c0 + 4), ba = *(const f32x4*)(lnb + 256 * g + c0), bb = *(const f32x4*)(lnb + 256 * g + c0 + 4);
                const float lg[8] = {ga.x, ga.y, ga.z, ga.w, gb.x, gb.y, gb.z, gb.w}, lb[8] = {ba.x, ba.y, ba.z, ba.w, bb.x, bb.y, bb.z, bb.w};
#pragma unroll
                for (int e = 0; e < 8; ++e) { const unsigned wa = rawA[it][e >> 1], wb = rawB[it][e >> 1]; const float xa = (e & 1) ? bfhi(wa) : bflo(wa), xb = (e & 1) ? bfhi(wb) : bflo(wb);
                    const float ya = (xa - meanA) * rstdA * lg[e] + lb[e], yb = (xb - meanB) * rstdB * lg[e] + lb[e];
                    *(LAS unsigned*)(Vt + (c0 + e) * LST + 4 * lane) = pk2(ya, yb); } } }
        __syncthreads();
        f32x4 acc[8][2];
#pragma unroll
        for (int m = 0; m < 8; ++m) { acc[m][0] = (f32x4){0.f, 0.f, 0.f, 0.f}; acc[m][1] = (f32x4){0.f, 0.f, 0.f, 0.f}; }
#pragma unroll
        for (int ks = 0; ks < 4; ++ks) { bf16x8 Bf[2];
#pragma unroll
            for (int n = 0; n < 2; ++n) Bf[n] = *(const LAS bf16x8*)(Vt + (32 * w + 16 * n + fr) * LST + (ks * 32 + fq * 8) * 2);
#pragma unroll
            for (int m = 0; m < 8; ++m) if (32 * ks <= 16 * m + 15) { const bf16x8 Af = *(const LAS bf16x8*)(Wl + (16 * m + fr) * LST + (ks * 32 + fq * 8) * 2);
#pragma unroll
                for (int n = 0; n < 2; ++n) acc[m][n] = __builtin_amdgcn_mfma_f32_16x16x32_bf16(Bf[n], Af, acc[m][n], 0, 0, 0); } }
#pragma unroll
        for (int m = 0; m < 8; ++m) { const int t = 16 * m + fr; const float b = bs[g * 128 + t];
#pragma unroll
            for (int n = 0; n < 2; ++n) { const int c = 32 * w + 16 * n + 4 * fq; v2u* p = (v2u*)(Z + (row0 + t) * 4096 + 256 * g + c); const v2u u2 = uu[m][n];
                const float o0 = bflo(u2.x) * (acc[m][n][0] + b), o1 = bfhi(u2.x) * (acc[m][n][1] + b), o2 = bflo(u2.y) * (acc[m][n][2] + b), o3 = bfhi(u2.y) * (acc[m][n][3] + b);
                if (do_store) *p = (v2u){pk2(o0, o1), pk2(o2, o3)}; } }
        __syncthreads();
    }
}
#define XB_TMO      128
#define XB_XCNT(j)  (256  + 64 * (j))
#define XB_XSUB(j)  (1280 + 64 * (j))
#define XB_XGEN(j)  (2304 + 64 * (j))
#define XB_TOP      3328
#define XB_TOPGEN   3392
#define XCD_BAR_WORDS 3456
#define XB_SPIN_CAP (1u << 18)

__device__ __forceinline__ unsigned xb_ld(unsigned* p)              { return __hip_atomic_load(p, __ATOMIC_RELAXED, __HIP_MEMORY_SCOPE_AGENT); }
__device__ __forceinline__ unsigned xb_add(unsigned* p, unsigned v) { return __hip_atomic_fetch_add(p, v, __ATOMIC_RELAXED, __HIP_MEMORY_SCOPE_AGENT); }
__device__ __forceinline__ unsigned xb_xcc_id() { return (unsigned)__builtin_amdgcn_s_getreg((3 << 11) | 20) & 0xFu; }
#define XB_SPIN(cond, bar) do { unsigned _sp = 0; while (cond) { __builtin_amdgcn_s_sleep(1); \
    if ((++_sp & 255u) == 0u) { if (xb_ld(&(bar)[XB_TMO])) break; if (_sp > XB_SPIN_CAP) { atomicAdd(&(bar)[XB_TMO], 1u); break; } } } } while (0)

struct XcdBarrier {
    unsigned* bar; unsigned x;
    volatile LAS unsigned* st;
};

__device__ __forceinline__ XcdBarrier xcd_barrier_post(unsigned* bar, volatile LAS unsigned* st) {
    XcdBarrier b; b.bar = bar; b.x = xb_xcc_id(); b.st = st;
    if (threadIdx.x == 0) st[3] = xb_add(&bar[XB_XCNT(b.x)], 1u);
    return b;
}
__device__ __forceinline__ void xcd_barrier_complete(unsigned* bar, unsigned x, unsigned& nloc, unsigned& nx, unsigned& uni) {
    const unsigned G = gridDim.x * gridDim.y * gridDim.z;
    unsigned sum, cnt, mine, sp = 0u;
    for (;;) {
        sum = 0u; cnt = 0u; mine = 0u;
#pragma unroll
        for (unsigned j = 0; j < 16; ++j) { const unsigned c = xb_ld(&bar[XB_XCNT(j)]); sum += c; cnt += (c > 0u) ? 1u : 0u; mine = (j == x) ? c : mine; }
        if (sum == G) break;
        __builtin_amdgcn_s_sleep(1);
        if ((++sp & 255u) == 0u) { if (xb_ld(&bar[XB_TMO])) break; if (sp > XB_SPIN_CAP) { atomicAdd(&bar[XB_TMO], 1u); break; } }
    }
    nloc = mine > 0u ? mine : 1u; nx = cnt > 0u ? cnt : 1u;
    unsigned ok = (sum == G && G == 256u && cnt == 8u) ? 1u : 0u, rank = 0u;
#pragma unroll
    for (unsigned j = 0; j < 16; ++j) { const unsigned c = xb_ld(&bar[XB_XCNT(j)]); if (c != 0u && c != 32u) ok = 0u; if (j < x && c > 0u) ++rank; }
    uni = ok ? 1u + rank : 0u;
}

__device__ __forceinline__ void xcd_barrier(const XcdBarrier& b, const bool local_only = false) {
    asm volatile("s_waitcnt vmcnt(0)" ::: "memory");
    __syncthreads();
    if (threadIdx.x == 0) {
        unsigned* bar = b.bar;
        __builtin_amdgcn_s_waitcnt(0);
        unsigned nloc = b.st[0], nx = b.st[1];
        if (nloc == 0u) { unsigned uni; xcd_barrier_complete(bar, b.x, nloc, nx, uni); b.st[0] = nloc; b.st[1] = nx; b.st[2] = uni; }
        const unsigned old = xb_add(&bar[XB_XSUB(b.x)], 1u);
        const unsigned gen = old / nloc;
        if (old + 1u == (gen + 1u) * nloc) {
            if (!local_only) {
            __builtin_amdgcn_fence(__ATOMIC_RELEASE, "agent");
            asm volatile("s_waitcnt vmcnt(0)" ::: "memory");
            const unsigned og = xb_add(&bar[XB_TOP], 1u);
            const unsigned tg = og / nx;
            if (og + 1u == (tg + 1u) * nx) xb_add(&bar[XB_TOPGEN], 1u);
            else XB_SPIN(xb_ld(&bar[XB_TOPGEN]) == tg, bar);
            }
            __builtin_amdgcn_fence(__ATOMIC_ACQUIRE, "agent");
            xb_add(&bar[XB_XGEN(b.x)], 1u);
            asm volatile("s_waitcnt vmcnt(0)" ::: "memory");
        } else {
            XB_SPIN(xb_ld(&bar[XB_XGEN(b.x)]) == gen, bar);
            __builtin_amdgcn_fence(__ATOMIC_ACQUIRE, "agent");
            asm volatile("s_waitcnt vmcnt(0)" ::: "memory");
        }
    }
    __syncthreads();
}
constexpr int CW_BAR = 1024;
struct Args { const float* in[16]; float* out; unsigned char* ws; int ph_lo, ph_hi; };
__global__ void __launch_bounds__(NWAVES * 64, 2) mk_fwd(Args args) {
    extern __shared__ __attribute__((aligned(16))) unsigned char lds[];
    Frame F; F.lds = (LAS unsigned char*)lds; F.wave = __builtin_amdgcn_readfirstlane((int)threadIdx.x >> 6); F.lane = 0; F.tid = 0; relaunder(F);
    F.G = gridDim.x; { const int bx = blockIdx.x; F.vcu = (F.G % 8 == 0) ? (bx % 8) * (F.G / 8) + bx / 8 : bx; } F.cid = (int)blockIdx.x;
    F.kp = (kptr_t)__builtin_amdgcn_kernarg_segment_ptr();
    volatile LAS unsigned* bst = (volatile LAS unsigned*)(F.lds + 131072);
    if (F.tid == 0) { bst[0] = 0u; bst[1] = 0u; bst[2] = 0u; bst[3] = 0u; }
    __syncthreads();
    XcdBarrier bar; bar.bar = (unsigned*)(KWS(F) + WS_CTL) + CW_BAR; bar.x = 0; bar.st = bst;
    if (args.ph_hi - args.ph_lo > 1) bar = xcd_barrier_post((unsigned*)(KWS(F) + WS_CTL) + CW_BAR, bst);
    const int lo = args.ph_lo, hi = args.ph_hi; int ph = 0;
    if (hi - lo > 1) cg::this_grid().sync();
#define REP(n) for (int rep_ = 0; rep_ < (n); ++rep_)
#define ws KWS(F)
#define out KOUT(F)
#define stats ((float*)(KWS(F) + WS_STATS))
#define logf ((float*)(KWS(F) + WS_LOGF))
#define XN ((bf16*)(KWS(F) + WS_XN))
#define BIG ((bf16*)(KWS(F) + WS_BIG))
#define xs ((float*)(KWS(F) + WS_XS))
#define IN_PH() (lo <= ph && ph < hi && relaunder(F))
#define END_PH() do { if (ph + 1 < hi) { bar.bar = (unsigned*)(KWS(F) + WS_CTL) + CW_BAR; xcd_barrier(bar, xlocal); } } while (0)
    bool xlocal = false;
    if (IN_PH()) { REP(RP_P0) { p0_prologue(F, KWS(F)); p0_rows(F, KWS(F)); } END_PH(); } ++ph;
    if (hi - lo > 1 && lo == 0) { const unsigned uni = __builtin_amdgcn_readfirstlane(bst[2]), lidx = __builtin_amdgcn_readfirstlane(bst[3]);
        if (uni != 0u && lidx < 32u) { xlocal = true; F.vcu = (int)((uni - 1u) * 32u + lidx); F.cid = (int)(lidx * 8u + (uni - 1u)); } }
    if (hi - lo > 1) { REP(RP_BAR) { bar.bar = (unsigned*)(KWS(F) + WS_CTL) + CW_BAR; xcd_barrier(bar); } }
    for (int L = 0; L < 4; ++L) {
        const int j = L >> 1; const bool fox = (L & 1) != 0;
        if (!fox) {
            if (IN_PH()) { pg8::Gemm g{XN, (const bf16*)(ws + WS_WIN_G + j * 8 * MiB), M, 4096, D, D, 0}; pg8::StaticOrder S; S.init(M, 4096, F.G, F.cid); pg8::Unit u0_; const int pm0_ = S.next(0, u0_) ? u0_.pm : -1; const f32x4 rsr_ = load_rs(F, xs, pm0_);
                pg8::EpiBf16<1> E{BIG, 4096, 0, 0, stats, 8, xs, (const LAS float*)(F.lds + 131072 + 8704), pm0_, rsr_, (LAS float*)(F.lds + 131072 + 8704)};
                REP(RP_G4) pg8::gemm_phase<pg8::EpiBf16<1>, pg8::StaticOrder, PG8_ALIGN, PG8_SP2>(F.lds, g, S, E, F.tid); END_PH(); } ++ph;
            if (IN_PH()) { REP(RP_SP) spatial_phase(F, BIG, stats, KIN(F, 2) + j * GE, KIN(F, 3) + j * GE, KIN(F, 4) + (size_t)j * 8 * 128 * 128, KIN(F, 5) + j * 8 * 128, rep_ + lo >= RP_SP - 1); END_PH(); } ++ph;
            if (IN_PH()) { pg8::Gemm g{BIG, (const bf16*)(ws + WS_WOUT_G + j * 4 * MiB), M, D, GE, 4096, 0}; pg8::StaticOrder S; S.init(M, D, F.G, F.cid);
                { pg8::EpiRes E{(const float*)nullptr, (float*)nullptr, XN, xs, D, (LAS float*)(F.lds + 131072 + 256)}; pg8::gemm_phase<pg8::EpiRes, pg8::StaticOrder, true, PG8_SP2>(F.lds, g, S, E, F.tid); } END_PH(); } ++ph;
        } else {
            bf16* Qb = BIG; bf16* Kb = BIG + (size_t)SEQ * D; bf16* Vb = BIG + 2 * (size_t)SEQ * D; bf16* Gb = BIG + 3 * (size_t)SEQ * D;
            if (IN_PH()) { flogit_prestep(F, XN, (const bf16*)(ws + WS_WF) + (size_t)j * 16 * D, xs, KIN(F, 8) + j * 16, logf);
                pg8::Gemm g{XN, (const bf16*)(ws + WS_WIN_F + j * 8 * MiB), M, 4096, D, D, 0}; pg8::StaticOrder S; S.init(M, 4096, F.G, F.cid); pg8::Unit u0_; const int pm0_ = S.next(0, u0_) ? u0_.pm : -1; const f32x4 rsr_ = load_rs(F, xs, pm0_);
                pg8::EpiQKVG E{BIG, D, (size_t)SEQ * D, xs, KIN(F, 9) + j * 64, KIN(F, 10) + j * 64, (LAS float*)(F.lds + 131072 + 256), attn_body::C2, (const LAS float*)(F.lds + 131072 + 8704), pm0_, (size_t)3 * SEQ * D, rsr_, (LAS float*)(F.lds + 131072 + 8704)};
                REP(RP_G4) pg8::gemm_phase<pg8::EpiQKVG, pg8::StaticOrder, true, PG8_SP2>(F.lds, g, S, E, F.tid); END_PH(); } ++ph;
            if (IN_PH()) { const attn_body::AttnTensors AT{(const attn_body::bf16*)Qb, (const attn_body::bf16*)Kb, (const attn_body::bf16*)Vb, (attn_body::bf16*)Qb, (const attn_body::bf16*)Gb, logf, qk_bound(F, KIN(F, 9) + j * 64, KIN(F, 10) + j * 64)};
                const attn_body::StaticOrder S(F.G, F.vcu);
                attn_body::attn_phase<attn_body::StaticOrder>((char*)lds, AT, S, F.tid); END_PH(); } ++ph;
            if (IN_PH()) { pg8::Gemm g{Qb, (const bf16*)(ws + WS_WOUT_F + j * 2 * MiB), M, D, D, D, (size_t)3 * SEQ * D * 2};     pg8::StaticOrder S; S.init(M, D, F.G, F.cid);
                { pg8::EpiRes E{(const float*)nullptr, (float*)nullptr, XN, xs, D, (LAS float*)(F.lds + 131072 + 256)}; pg8::gemm_phase<pg8::EpiRes, pg8::StaticOrder, true, PG8_SP2>(F.lds, g, S, E, F.tid); } END_PH(); } ++ph;
        }
        if (IN_PH()) { pg8::Gemm g{XN, (const bf16*)(ws + WS_W1 + L * 8 * MiB), M, FF, D, D, 0}; pg8::StaticOrder S; S.init(M, FF, F.G, F.cid); pg8::Unit u0_; const int pm0_ = S.next(0, u0_) ? u0_.pm : -1; const f32x4 rsr_ = load_rs(F, xs, pm0_);
            pg8::EpiBf16<2> E{BIG, FF, 0, 0, nullptr, 0, xs, (const LAS float*)(F.lds + 131072 + 8704), pm0_, rsr_, (LAS float*)(F.lds + 131072 + 8704)};
            REP(RP_G4) pg8::gemm_phase<pg8::EpiBf16<2>, pg8::StaticOrder, PG8_ALIGN, PG8_SP2>(F.lds, g, S, E, F.tid); END_PH(); } ++ph;
        if (IN_PH()) { pg8::Gemm g{BIG, (const bf16*)(ws + WS_W2 + L * 8 * MiB), M, D, FF, FF, 0}; pg8::StaticOrder S; S.init(M, D, F.G, F.cid);
            { pg8::EpiRes E{(const float*)nullptr, (L == 3) ? out : (float*)nullptr, XN, xs, D, (LAS float*)(F.lds + 131072 + 256)}; pg8::gemm_phase<pg8::EpiRes, pg8::StaticOrder, true, PG8_SP2>(F.lds, g, S, E, F.tid); } END_PH(); } ++ph;
    }
#undef IN_PH
#undef ws
#undef out
#undef stats
#undef logf
#undef XN
#undef BIG
#undef xs
#undef END_PH
}

extern "C" void kernel_launch(void* const* d_in, const int* in_sizes, int n_in, void* d_out, int out_size, void* d_ws, size_t ws_size, hipStream_t stream) {
    static int grid = 0;
    if (grid == 0) {
        if (n_in != 16 || out_size != M * D || ws_size < WS_END) { fprintf(stderr, "kernel_launch: unexpected shapes: n_in %d out %d ws %zu (need %zu)\n", n_in, out_size, ws_size, (size_t)WS_END); grid = -1; return; }
        int dev = 0, cus = 0, per_cu = 0;
        if (hipGetDevice(&dev) != hipSuccess || hipDeviceGetAttribute(&cus, hipDeviceAttributeMultiprocessorCount, dev) != hipSuccess) { grid = -1; return; }
        if (hipFuncSetAttribute((const void*)mk_fwd, hipFuncAttributeMaxDynamicSharedMemorySize, LDS_BYTES) != hipSuccess) { fprintf(stderr, "kernel_launch: hipFuncSetAttribute failed\n"); grid = -1; return; }
        if (hipOccupancyMaxActiveBlocksPerMultiprocessor(&per_cu, (const void*)mk_fwd, NWAVES * 64, LDS_BYTES) != hipSuccess || per_cu < 1) { fprintf(stderr, "kernel_launch: occupancy query says %d blocks/CU\n", per_cu); per_cu = 1; }
        (void)hipGetLastError();
        grid = cus;
    }
    if (grid < 0) return;
    if (hipMemsetAsync((char*)d_ws + WS_CTL, 0, 65536, stream) != hipSuccess) { fprintf(stderr, "kernel_launch: hipMemsetAsync failed\n"); return; }
    Args a{};
    for (int i = 0; i < 16; ++i) a.in[i] = (const float*)d_in[i];
    a.out = (float*)d_out; a.ws = (unsigned char*)d_ws;
#if MK_ONE_LAUNCH
    a.ph_lo = 0; a.ph_hi = NPHASES;
    void* params[] = {&a};
    hipError_t e = hipLaunchCooperativeKernel((const void*)mk_fwd, dim3(grid), dim3(NWAVES * 64), params, LDS_BYTES, stream);
    if (e != hipSuccess) fprintf(stderr, "kernel_launch: cooperative launch failed: %s (grid %d)\n", hipGetErrorString(e), grid);
#else
    for (int p = 0; p < NPHASES; ++p) { a.ph_lo = p; a.ph_hi = p + 1; hipLaunchKernelGGL(mk_fwd, dim3(grid), dim3(NWAVES * 64), LDS_BYTES, stream, a); }
#endif
}
```

```cpp
#include <hip/hip_runtime.h>
#include <hip/hip_cooperative_groups.h>
#include <cstdio>
#include <cstdint>
#ifndef PG8_SP2
#define PG8_SP2 true
#endif
#ifndef PG8_ALIGN
#define PG8_ALIGN true
#endif
#ifndef MK_ONE_LAUNCH
#define MK_ONE_LAUNCH 1
#endif
#ifndef RP_P0
#define RP_P0 1
#endif
#ifndef RP_G4
#define RP_G4 1
#endif
#ifndef RP_SP
#define RP_SP 1
#endif
#ifndef RP_BAR
#define RP_BAR 0
#endif
namespace pg8 {
#define PG8_LAS __attribute__((address_space(3)))
typedef unsigned short bf16_t;
typedef short bf16x8 __attribute__((ext_vector_type(8)));
typedef float f32x4 __attribute__((ext_vector_type(4)));
typedef unsigned u32x4 __attribute__((ext_vector_type(4)));
constexpr int BM = 256, BK = 64, HALF = 128, HTB = HALF * BK * 2  , STAGE_BYTES = 8 * HTB, NXCD = 8, WGM = 8;

__host__ __device__ __forceinline__ int lds_byte(int r, int c) { const int st = (r >> 4) * 2 + (c >> 5), rr = r & 15, cc = c & 31, ob = rr * 64 + cc * 2; return st * 1024 + (ob ^ (((ob >> 9) & 1) << 5)); }
__host__ __device__ __forceinline__ void stage_rc(int b, int& R, int& C) { const int st = b / 1024, sb = b % 1024, swz = sb ^ (((sb >> 9) & 1) << 5); R = (st >> 1) * 16 + swz / 64; C = (st & 1) * 32 + (swz % 64) / 2; }
__host__ __device__ __forceinline__ int perm32(int rho) { const int n = rho >> 4, i = rho & 15; return 8 * (i >> 2) + 4 * n + (i & 3); }

struct Unit { int pm, pn; };
struct Gemm { const bf16_t* A; const bf16_t* Bt; int M, N, K, lda; size_t abx; };

struct StaticOrder {
    int nM, nN, nwg, G, c;
    __host__ __device__ __forceinline__ void init(int M, int N, int G_, int c_) { nM = M / BM; nN = N / BM; nwg = nM * nN; G = G_; c = c_; }
    __host__ __device__ __forceinline__ bool next(int i, Unit& u) const {
        const long L = (long)i * G + c; if (L >= nwg) return false;
        int wgid = (int)L; { const int q = nwg / NXCD, r = nwg % NXCD, xcd = wgid % NXCD, off = wgid / NXCD; wgid = (xcd < r ? xcd * (q + 1) : r * (q + 1) + (xcd - r) * q) + off; }
        const int nig = WGM * nN, gid = wgid / nig, fm = gid * WGM, gsz = (nM - fm) < WGM ? (nM - fm) : WGM;
        u.pm = fm + ((wgid % nig) % gsz); u.pn = (wgid % nig) / gsz; return true;
    }
    __device__ __forceinline__ void a_ready(const Unit&) const {}
    __device__ __forceinline__ void done(const Unit&) const {}
};
__device__ __forceinline__ unsigned cvt_pk_bf16(float lo, float hi) { unsigned r; asm volatile("v_cvt_pk_bf16_f32 %0, %1, %2" : "=v"(r) : "v"(lo), "v"(hi)); return r; }
__device__ __forceinline__ float fq_sum(float v) {
    { const auto r = __builtin_amdgcn_permlane16_swap(__float_as_uint(v), __float_as_uint(v), false, false); v = __uint_as_float(r[0]) + __uint_as_float(r[1]); }
    { const auto r = __builtin_amdgcn_permlane32_swap(__float_as_uint(v), __float_as_uint(v), false, false); v = __uint_as_float(r[0]) + __uint_as_float(r[1]); }
    return v;
}
__device__ __forceinline__ float gelu_tanh(float x) {
    const float u = x * (1.0f + 0.044715f * x * x);
    const float e = __builtin_amdgcn_exp2f(-2.3022081985f * u);
    return x * __builtin_amdgcn_rcpf(1.0f + e);
}
typedef float f32x2 __attribute__((ext_vector_type(2)));
template <int ACT> struct EpiBf16 {
    static constexpr bool PERM = true, AFTER_DRAIN = false, HAS_INIT = false, HAS_PRE = true;
    bf16_t* O; int ldc; int split_cols; size_t split_stride; float* stats; int stats_pn0; const float* xs; const PG8_LAS float* rsl; int rs_pm;
    f32x4 rs_raw; PG8_LAS float* rsl_w;
    __device__ __forceinline__ void pre(int tid) const { if (tid < BM) rsl_w[tid] = 1.0f / sqrtf(((rs_raw[0] + rs_raw[1]) + (rs_raw[2] + rs_raw[3])) * (1.0f / 1024.0f) + 1e-6f); }
    __device__ __forceinline__ void operator()(const f32x4 (&acc)[2][2][4][2], const Unit& u, int wr, int wc, int fr, int fq) const {
        const int row0 = u.pm * BM + wr * 64 + fr; int colt = u.pn * BM; bf16_t* base = O;
        if (split_cols) { const int t = colt / split_cols; base += (size_t)t * split_stride; colt -= t * split_cols; }
        const int col0 = colt + wc * 32 + 8 * fq;
        const bool do_stats = (ACT == 1) && (u.pn >= stats_pn0);
        float rsv[2][4];
        if (u.pm == rs_pm) {
#pragma unroll
          for (int ai = 0; ai < 2; ++ai)
#pragma unroll
            for (int m = 0; m < 4; ++m) rsv[ai][m] = rsl[wr * 64 + fr + ai * HALF + m * 16];
        } else { f32x4 xq[2][4];
#pragma unroll
          for (int ai = 0; ai < 2; ++ai)
#pragma unroll
            for (int m = 0; m < 4; ++m) xq[ai][m] = *(const f32x4*)(xs + (size_t)(row0 + ai * HALF + m * 16) * 4);
#pragma unroll
          for (int ai = 0; ai < 2; ++ai)
#pragma unroll
            for (int m = 0; m < 4; ++m) rsv[ai][m] = 1.0f / sqrtf(((xq[ai][m][0] + xq[ai][m][1]) + (xq[ai][m][2] + xq[ai][m][3])) * (1.0f / 1024.0f) + 1e-6f); }
#pragma unroll
        for (int ai = 0; ai < 2; ++ai)
#pragma unroll
            for (int m = 0; m < 4; ++m) { const int row = row0 + ai * HALF + m * 16; bf16_t* rowp = base + (size_t)row * ldc + col0; float s1 = 0.f, s2 = 0.f;
                const float rs = rsv[ai][m];
#pragma unroll
                for (int bj = 0; bj < 2; ++bj) { f32x4 v0 = acc[ai][bj][m][0] * rs, v1 = acc[ai][bj][m][1] * rs;
                    if (ACT == 1) {
#pragma unroll
                        for (int e = 0; e < 4; ++e) { v0[e] = gelu_tanh(v0[e]); v1[e] = gelu_tanh(v1[e]); }
                        s1 += ((v0[0] + v0[1]) + (v0[2] + v0[3])) + ((v1[0] + v1[1]) + (v1[2] + v1[3]));
                        s2 += ((v0[0] * v0[0] + v0[1] * v0[1]) + (v0[2] * v0[2] + v0[3] * v0[3])) + ((v1[0] * v1[0] + v1[1] * v1[1]) + (v1[2] * v1[2] + v1[3] * v1[3]));
                    }
                    if (ACT == 2) {
#pragma unroll
                        for (int e = 0; e < 4; ++e) { const float a = __builtin_fmaxf(v0[e], 0.f), b = __builtin_fmaxf(v1[e], 0.f); v0[e] = a * a; v1[e] = b * b; }
                    }
                    u32x4 w; w.x = cvt_pk_bf16(v0[0], v0[1]); w.y = cvt_pk_bf16(v0[2], v0[3]); w.z = cvt_pk_bf16(v1[0], v1[1]); w.w = cvt_pk_bf16(v1[2], v1[3]);
                    *(u32x4*)(rowp + bj * HALF) = w; }
                if (ACT == 1) { if (do_stats) {
                    s1 = fq_sum(s1); s2 = fq_sum(s2);
                    if (fq == 0) *(f32x2*)(stats + ((size_t)row * 32 + (u.pn - stats_pn0) * 4 + wc) * 2) = (f32x2){s1, s2}; } }
            }
    }
};
struct EpiQKVG {
    static constexpr bool PERM = true, AFTER_DRAIN = false, HAS_INIT = false, HAS_PRE = true;
    bf16_t* O; int ldc; size_t split_stride; const float* xs; const float* qg; const float* kg; PG8_LAS float* xl; float qscale; const PG8_LAS float* rsl; int rs_pm; size_t batch_extra;
    f32x4 rs_raw; PG8_LAS float* rsl_w;
    __device__ __forceinline__ void pre(int tid) const { if (tid < BM) rsl_w[tid] = 1.0f / sqrtf(((rs_raw[0] + rs_raw[1]) + (rs_raw[2] + rs_raw[3])) * (1.0f / 1024.0f) + 1e-6f); }

    __device__ __forceinline__ void operator()(const f32x4 (&acc)[2][2][4][2], const Unit& u, int wr, int wc, int fr, int fq) const {
        const int row0 = u.pm * BM + wr * 64 + fr; const int t = u.pn >> 2; bf16_t* base = O + (size_t)t * split_stride + (size_t)(u.pm >> 3) * batch_extra;
        const int col0 = (u.pn & 3) * BM + wc * 32 + 8 * fq;
        float rsv[2][4];
        if (u.pm == rs_pm) {
#pragma unroll
          for (int ai = 0; ai < 2; ++ai)
#pragma unroll
            for (int m = 0; m < 4; ++m) rsv[ai][m] = rsl[wr * 64 + fr + ai * HALF + m * 16];
        } else
#pragma unroll
        for (int ai = 0; ai < 2; ++ai) { f32x4 xq[4];
#pragma unroll
            for (int m = 0; m < 4; ++m) xq[m] = *(const f32x4*)(xs + (size_t)(row0 + ai * HALF + m * 16) * 4);
#pragma unroll
            for (int m = 0; m < 4; ++m) rsv[ai][m] = 1.0f / sqrtf(((xq[m][0] + xq[m][1]) + (xq[m][2] + xq[m][3])) * (1.0f / 1024.0f) + 1e-6f);
            asm volatile("" ::: "memory"); }
        if (t < 2) {
#pragma unroll
            for (int ai = 0; ai < 2; ++ai)
#pragma unroll
                for (int m = 0; m < 4; ++m)
#pragma unroll
                    for (int bj = 0; bj < 2; ++bj) { const f32x4 v0 = acc[ai][bj][m][0], v1 = acc[ai][bj][m][1];
                        float ss = ((v0[0] * v0[0] + v0[1] * v0[1]) + (v0[2] * v0[2] + v0[3] * v0[3])) + ((v1[0] * v1[0] + v1[1] * v1[1]) + (v1[2] * v1[2] + v1[3] * v1[3]));
                        ss = fq_sum(ss); ss *= rsv[ai][m] * rsv[ai][m];
                        if (fq == 0) xl[((ai * HALF + wr * 64 + m * 16 + fr) * 2 + bj) * 4 + wc] = ss; asm volatile("" ::: "memory"); }
            asm volatile("s_waitcnt lgkmcnt(0)" ::: "memory"); __builtin_amdgcn_s_barrier(); asm volatile("" ::: "memory");
            const float* gp = (t == 0 ? qg : kg) + 32 * (wc & 1) + 8 * fq; const f32x4 g0 = *(const f32x4*)gp, g1 = *(const f32x4*)(gp + 4); const float sc = (t == 0) ? qscale : 1.0f;
#pragma unroll
            for (int ai = 0; ai < 2; ++ai)
#pragma unroll
                for (int m = 0; m < 4; ++m) { const int rl = ai * HALF + wr * 64 + m * 16 + fr; bf16_t* rowp = base + (size_t)(u.pm * BM + rl) * ldc + col0;
#pragma unroll
                    for (int bj = 0; bj < 2; ++bj) { const f32x2 pr = *(const PG8_LAS f32x2*)(xl + (rl * 2 + bj) * 4 + (wc & 2)); const float tot = pr[0] + pr[1];
                        const float hr = sc * rsv[ai][m] / sqrtf(tot * (1.0f / 64.0f) + 1e-6f);
                        const f32x4 v0 = acc[ai][bj][m][0] * hr * g0, v1 = acc[ai][bj][m][1] * hr * g1;
                        u32x4 w; w.x = cvt_pk_bf16(v0[0], v0[1]); w.y = cvt_pk_bf16(v0[2], v0[3]); w.z = cvt_pk_bf16(v1[0], v1[1]); w.w = cvt_pk_bf16(v1[2], v1[3]);
                        *(u32x4*)(rowp + bj * HALF) = w; }
                    asm volatile("" ::: "memory"); }
        } else {
#pragma unroll
            for (int ai = 0; ai < 2; ++ai)
#pragma unroll
                for (int m = 0; m < 4; ++m) { bf16_t* rowp = base + (size_t)(row0 + ai * HALF + m * 16) * ldc + col0; const float rs = rsv[ai][m];
#pragma unroll
                    for (int bj = 0; bj < 2; ++bj) { const f32x4 v0 = acc[ai][bj][m][0] * rs, v1 = acc[ai][bj][m][1] * rs;
                        u32x4 w; w.x = cvt_pk_bf16(v0[0], v0[1]); w.y = cvt_pk_bf16(v0[2], v0[3]); w.z = cvt_pk_bf16(v1[0], v1[1]); w.w = cvt_pk_bf16(v1[2], v1[3]);
                        *(u32x4*)(rowp + bj * HALF) = w; } }
        }
    }
};
struct EpiRes {
    static constexpr bool PERM = true, AFTER_DRAIN = false, HAS_INIT = true, HAS_PRE = false;
    const float* base32; float* out32; bf16_t* xn; float* xs; int ldc; PG8_LAS float* xl;
    __device__ __forceinline__ void init_slow(f32x4 (&acc)[2][2][4][2], const Unit& u, int wr, int wc, int fr, int fq) const {
        const int col0 = u.pn * BM + wc * 32 + 8 * fq;
#pragma unroll
        for (int ai = 0; ai < 2; ++ai)
#pragma unroll
            for (int m = 0; m < 4; ++m) { const size_t off = (size_t)(u.pm * BM + ai * HALF + wr * 64 + m * 16 + fr) * ldc + col0;
#pragma unroll
                for (int bj = 0; bj < 2; ++bj) { const size_t p = off + bj * HALF;
                    if (base32) { acc[ai][bj][m][0] = *(const f32x4*)(base32 + p); acc[ai][bj][m][1] = *(const f32x4*)(base32 + p + 4); }
                    else { const u32x4 r = *(const u32x4*)(xn + p); acc[ai][bj][m][0] = (f32x4){__uint_as_float(r.x << 16), __uint_as_float(r.x & 0xffff0000u), __uint_as_float(r.y << 16), __uint_as_float(r.y & 0xffff0000u)};
                        acc[ai][bj][m][1] = (f32x4){__uint_as_float(r.z << 16), __uint_as_float(r.z & 0xffff0000u), __uint_as_float(r.w << 16), __uint_as_float(r.w & 0xffff0000u)}; }
                    asm volatile("" : "+v"(acc[ai][bj][m][0]), "+v"(acc[ai][bj][m][1]) :: "memory"); } }
    }
    __device__ __forceinline__ void init(f32x4 (&acc)[2][2][4][2], const Unit& u, int wr, int wc, int fr, int fq) const {
        const int col0 = u.pn * BM + wc * 32 + 8 * fq;
#pragma unroll
        for (int ai = 0; ai < 2; ++ai)
#pragma unroll
            for (int m = 0; m < 4; ++m) { const size_t off = (size_t)(u.pm * BM + ai * HALF + wr * 64 + m * 16 + fr) * ldc + col0;
#pragma unroll
                for (int bj = 0; bj < 2; ++bj) { const size_t p = off + bj * HALF;
                    if (base32) { acc[ai][bj][m][0] = *(const f32x4*)(base32 + p); acc[ai][bj][m][1] = *(const f32x4*)(base32 + p + 4); }
                    else { const u32x4 r = *(const u32x4*)(xn + p); acc[ai][bj][m][0] = (f32x4){__uint_as_float(r.x << 16), __uint_as_float(r.x & 0xffff0000u), __uint_as_float(r.y << 16), __uint_as_float(r.y & 0xffff0000u)};
                        acc[ai][bj][m][1] = (f32x4){__uint_as_float(r.z << 16), __uint_as_float(r.z & 0xffff0000u), __uint_as_float(r.w << 16), __uint_as_float(r.w & 0xffff0000u)}; } } }
#pragma unroll
        for (int ai = 0; ai < 2; ++ai)
#pragma unroll
            for (int bj = 0; bj < 2; ++bj)
#pragma unroll
                for (int m = 0; m < 4; ++m) asm volatile("" : "+v"(acc[ai][bj][m][0]), "+v"(acc[ai][bj][m][1]));
    }
    __device__ __forceinline__ void operator()(const f32x4 (&acc)[2][2][4][2], const Unit& u, int wr, int wc, int fr, int fq) const {
        const int col0 = u.pn * BM + wc * 32 + 8 * fq;
#pragma unroll
        for (int ai = 0; ai < 2; ++ai)
#pragma unroll
            for (int m = 0; m < 4; ++m) { const int row = u.pm * BM + ai * HALF + wr * 64 + m * 16 + fr; const size_t off = (size_t)row * ldc + col0; float ss = 0.f;
#pragma unroll
                for (int bj = 0; bj < 2; ++bj) { const size_t p = off + bj * HALF; const f32x4 v0 = acc[ai][bj][m][0], v1 = acc[ai][bj][m][1];
                    ss += ((v0[0] * v0[0] + v0[1] * v0[1]) + (v0[2] * v0[2] + v0[3] * v0[3])) + ((v1[0] * v1[0] + v1[1] * v1[1]) + (v1[2] * v1[2] + v1[3] * v1[3]));
                    if (out32) { *(f32x4*)(out32 + p) = v0; *(f32x4*)(out32 + p + 4) = v1; }
                    if (!out32) { u32x4 w; w.x = cvt_pk_bf16(v0[0], v0[1]); w.y = cvt_pk_bf16(v0[2], v0[3]); w.z = cvt_pk_bf16(v1[0], v1[1]); w.w = cvt_pk_bf16(v1[2], v1[3]);
                    *(u32x4*)(xn + p) = w; } }
                ss = fq_sum(ss);
                if (fq == 0) xl[(ai * HALF + wr * 64 + m * 16 + fr) * 4 + wc] = ss;
                asm volatile("" ::: "memory"); }
        asm volatile("s_waitcnt lgkmcnt(0)" ::: "memory"); __builtin_amdgcn_s_barrier(); asm volatile("" ::: "memory");
        { const int t = (wr * 4 + wc) * 64 + fq * 16 + fr;
          if (t < BM) { const f32x4 q = *(const PG8_LAS f32x4*)(xl + t * 4); xs[(size_t)(u.pm * BM + t) * 4 + u.pn] = (q[0] + q[1]) + (q[2] + q[3]); } }
    }
};

template <class Epi, class Sched, bool ALIGN_EPI = false, bool SP2 = false>
__device__ __forceinline__ void gemm_phase(PG8_LAS unsigned char* lds, const Gemm g, const Sched& S, const Epi& E, const int tid_in) {
    const int tid = tid_in, wid = __builtin_amdgcn_readfirstlane(tid >> 6), lane = tid & 63, wr = wid >> 2, wc = wid & 3, fr = lane & 15, fq = lane >> 4;
    const int K = g.K, nt = K / BK;
    unsigned voffA[2], voffB[2];
#pragma unroll
    for (int i = 0; i < 2; ++i) { int R, C; stage_rc(tid * 16 + i * 8192, R, C); const int Rb = Epi::PERM ? ((R & ~31) + perm32(R & 31)) : R;
        voffA[i] = (unsigned)(R * g.lda + C) * 2u; voffB[i] = (unsigned)(Rb * K + C) * 2u; }
    const size_t kstep = (size_t)(BK * 2);
    const size_t hstepB = (size_t)HALF * K * 2, hstepA = (size_t)HALF * g.lda * 2;
    const size_t tstepB = 2 * hstepB, tstepA = 2 * hstepA;
    const unsigned ldsw = (unsigned)wid * 1024u;
    const int aoff = lds_byte(wr * 64 + fr, fq * 8), boff = lds_byte(wc * 32 + fr, fq * 8);
#define PG8_SA(b, h) (((b) * 2 + (h)) * HTB)
#define PG8_SB(b, h) ((4 + (b) * 2 + (h)) * HTB)
#define PG8_STAGE(bufoff, gbase, voff) do { _Pragma("unroll") for (int _i = 0; _i < 2; ++_i) \
        __builtin_amdgcn_global_load_lds((const unsigned*)((const char*)(gbase) + (voff)[_i]), (PG8_LAS unsigned*)(lds + (bufoff) + ldsw + _i * 8192), 16, 0, 0); } while (0)
#define PG8_LDA(dst, b, h) do { _Pragma("unroll") for (int m = 0; m < 4; ++m) _Pragma("unroll") for (int k = 0; k < 2; ++k) dst[m][k] = *(const PG8_LAS bf16x8*)(lds + PG8_SA(b, h) + aoff + m * 2048 + k * 1024); } while (0)
#define PG8_LDB(dst, b, h) do { _Pragma("unroll") for (int n = 0; n < 2; ++n) _Pragma("unroll") for (int k = 0; k < 2; ++k) dst[n][k] = *(const PG8_LAS bf16x8*)(lds + PG8_SB(b, h) + boff + n * 2048 + k * 1024); } while (0)
#define PG8_MMA(ai, bj, At, Bt) do { __builtin_amdgcn_s_setprio(1); _Pragma("unroll") for (int m = 0; m < 4; ++m) _Pragma("unroll") for (int n = 0; n < 2; ++n) _Pragma("unroll") for (int k = 0; k < 2; ++k) \
        acc[ai][bj][m][n] = __builtin_amdgcn_mfma_f32_16x16x32_bf16(Bt[n][k], At[m][k], acc[ai][bj][m][n], 0, 0, 0); __builtin_amdgcn_s_setprio(0); } while (0)
#define PG8_WAIT_V(n) asm volatile("s_waitcnt vmcnt(" #n ")" ::: "memory")
#define PG8_WAIT_L(n) asm volatile("s_waitcnt lgkmcnt(" #n ")" ::: "memory")
#define PG8_BAR __builtin_amdgcn_s_barrier()
#define PG8_SCHED __builtin_amdgcn_sched_barrier(0)
    Unit cur, nxt; int ui = 0;
    if (!S.next(0, cur)) return;
    f32x4 acc[2][2][4][2];
    if constexpr (Epi::HAS_INIT) { E.init(acc, cur, wr, wc, fr, fq); }
    else {
#pragma unroll
    for (int a = 0; a < 2; ++a)
#pragma unroll
        for (int b = 0; b < 2; ++b)
#pragma unroll
            for (int m = 0; m < 4; ++m)
#pragma unroll
                for (int n = 0; n < 2; ++n) acc[a][b][m][n] = (f32x4){0.f, 0.f, 0.f, 0.f};
    }
    bf16x8 At[4][2], B0[2][2], B1[2][2];
    const char* cA = (const char*)g.A + (size_t)cur.pm * tstepA + (size_t)(cur.pm >> 3) * g.abx; const char* cB = (const char*)g.Bt + (size_t)cur.pn * tstepB;
    S.a_ready(cur);
    if constexpr (SP2) {
        PG8_STAGE(PG8_SB(0, 0), cB, voffB); PG8_STAGE(PG8_SB(0, 1), cB + hstepB, voffB); PG8_STAGE(PG8_SA(0, 0), cA, voffA); PG8_STAGE(PG8_SA(0, 1), cA + hstepA, voffA);
        if (wr == 1) PG8_BAR;
        PG8_WAIT_V(2); PG8_BAR;
        PG8_STAGE(PG8_SB(1, 0), cB + kstep, voffB); PG8_STAGE(PG8_SA(1, 0), cA + kstep, voffA); PG8_STAGE(PG8_SB(1, 1), cB + hstepB + kstep, voffB);
        PG8_WAIT_V(6); PG8_BAR;
    } else {
        PG8_STAGE(PG8_SB(0, 0), cB, voffB); PG8_STAGE(PG8_SA(0, 0), cA, voffA); PG8_STAGE(PG8_SB(0, 1), cB + hstepB, voffB); PG8_STAGE(PG8_SA(0, 1), cA + hstepA, voffA);
        if (wr == 1) PG8_BAR;
        PG8_WAIT_V(4); PG8_BAR;
        PG8_STAGE(PG8_SB(1, 0), cB + kstep, voffB); PG8_STAGE(PG8_SA(1, 0), cA + kstep, voffA); PG8_STAGE(PG8_SB(1, 1), cB + hstepB + kstep, voffB);
        PG8_WAIT_V(6); PG8_BAR;
    }
    if constexpr (Epi::HAS_PRE) E.pre(tid);
    for (;;) {
        const bool has_next = S.next(ui + 1, nxt);
        const char* nA = has_next ? (const char*)g.A + (size_t)nxt.pm * tstepA + (size_t)(nxt.pm >> 3) * g.abx : cA; const char* nB = has_next ? (const char*)g.Bt + (size_t)nxt.pn * tstepB : cB;
        for (int t = 0; t < nt; t += 2) {
            const bool last = (t == nt - 2);
            const char* a1 = cA + (size_t)(t + 1) * kstep;
            const char* a2 = last ? nA : cA + (size_t)(t + 2) * kstep; const char* b2 = last ? nB : cB + (size_t)(t + 2) * kstep;
            const char* a3 = a2 + kstep; const char* b3 = b2 + kstep;
            if (last && has_next) S.a_ready(nxt);
            if constexpr (SP2) {
            PG8_LDB(B0, 0, 0); PG8_LDB(B1, 0, 1); PG8_SCHED; PG8_LDA(At, 0, 0); PG8_STAGE(PG8_SA(1, 1), a1 + hstepA, voffA);
            PG8_WAIT_V(8); PG8_WAIT_L(0); PG8_BAR; PG8_MMA(0, 0, At, B0); PG8_MMA(0, 1, At, B1); PG8_BAR; PG8_SCHED;
            PG8_LDA(At, 0, 1); PG8_STAGE(PG8_SB(0, 0), b2, voffB); PG8_STAGE(PG8_SB(0, 1), b2 + hstepB, voffB); PG8_STAGE(PG8_SA(0, 0), a2, voffA);
            PG8_WAIT_V(8); PG8_WAIT_L(0); PG8_BAR; PG8_MMA(1, 0, At, B0); PG8_MMA(1, 1, At, B1); PG8_BAR; PG8_SCHED;
            PG8_LDB(B0, 1, 0); PG8_LDB(B1, 1, 1); PG8_SCHED; PG8_LDA(At, 1, 0); PG8_STAGE(PG8_SA(0, 1), a2 + hstepA, voffA);
            PG8_WAIT_V(8); PG8_WAIT_L(0); PG8_BAR; PG8_MMA(0, 0, At, B0); PG8_MMA(0, 1, At, B1); PG8_BAR; PG8_SCHED;
            PG8_LDA(At, 1, 1); PG8_STAGE(PG8_SB(1, 0), b3, voffB); PG8_STAGE(PG8_SB(1, 1), b3 + hstepB, voffB); PG8_STAGE(PG8_SA(1, 0), a3, voffA);
            PG8_WAIT_V(8); PG8_WAIT_L(0); PG8_BAR; PG8_MMA(1, 0, At, B0); PG8_MMA(1, 1, At, B1); PG8_BAR; PG8_SCHED;
            } else {
            PG8_LDB(B0, 0, 0); PG8_SCHED; PG8_LDA(At, 0, 0); PG8_STAGE(PG8_SA(1, 1), a1 + hstepA, voffA);
            PG8_WAIT_L(8); PG8_BAR; PG8_WAIT_L(0); PG8_MMA(0, 0, At, B0); PG8_BAR; PG8_SCHED;
            PG8_LDB(B1, 0, 1); PG8_STAGE(PG8_SB(0, 0), b2, voffB);
            PG8_BAR; PG8_WAIT_L(0); PG8_MMA(0, 1, At, B1); PG8_BAR;
            PG8_LDA(At, 0, 1); PG8_STAGE(PG8_SA(0, 0), a2, voffA);
            PG8_BAR; PG8_WAIT_L(0); PG8_MMA(1, 0, At, B0); PG8_BAR; PG8_SCHED;
            PG8_STAGE(PG8_SB(0, 1), b2 + hstepB, voffB);
            PG8_WAIT_V(6); PG8_BAR; PG8_MMA(1, 1, At, B1); PG8_BAR;
            PG8_LDB(B0, 1, 0); PG8_SCHED; PG8_LDA(At, 1, 0); PG8_STAGE(PG8_SA(0, 1), a2 + hstepA, voffA);
            PG8_WAIT_L(8); PG8_BAR; PG8_WAIT_L(0); PG8_MMA(0, 0, At, B0); PG8_BAR; PG8_SCHED;
            PG8_LDB(B1, 1, 1); PG8_STAGE(PG8_SB(1, 0), b3, voffB);
            PG8_BAR; PG8_WAIT_L(0); PG8_MMA(0, 1, At, B1); PG8_BAR;
            PG8_LDA(At, 1, 1); PG8_STAGE(PG8_SA(1, 0), a3, voffA);
            PG8_BAR; PG8_WAIT_L(0); PG8_MMA(1, 0, At, B0); PG8_BAR; PG8_SCHED;
            PG8_STAGE(PG8_SB(1, 1), b3 + hstepB, voffB);
            PG8_WAIT_V(6); PG8_BAR; PG8_MMA(1, 1, At, B1); PG8_BAR;
            }
        }
        if constexpr (ALIGN_EPI) { if (wr == 0) PG8_BAR; }
        if constexpr (!Epi::AFTER_DRAIN) { E(acc, cur, wr, wc, fr, fq); S.done(cur); }
        if (!has_next) break;
        if constexpr (Epi::HAS_INIT) { E.init_slow(acc, nxt, wr, wc, fr, fq); } else
#pragma unroll
        for (int a = 0; a < 2; ++a)
#pragma unroll
            for (int b = 0; b < 2; ++b)
#pragma unroll
                for (int m = 0; m < 4; ++m)
#pragma unroll
                    for (int n = 0; n < 2; ++n) acc[a][b][m][n] = (f32x4){0.f, 0.f, 0.f, 0.f};
        cur = nxt; cA = nA; cB = nB; ++ui;
        if constexpr (ALIGN_EPI) { if (wr == 1) PG8_BAR; }
    }
    PG8_WAIT_V(0);
    if constexpr (!ALIGN_EPI) { if (wr == 0) PG8_BAR; }
    PG8_BAR;
    if constexpr (Epi::AFTER_DRAIN) { E.fused(acc, cur, wr, wc, fr, fq, lds, wid, lane); S.done(cur); }
#undef PG8_SA
#undef PG8_SB
#undef PG8_STAGE
#undef PG8_LDA
#undef PG8_LDB
#undef PG8_MMA
#undef PG8_WAIT_V
#undef PG8_WAIT_L
#undef PG8_BAR
#undef PG8_SCHED
}
}
#include <hip/hip_bf16.h>
#include <cmath>
namespace attn_body {
using bf16=__hip_bfloat16;
using bf16x8=__attribute__((ext_vector_type(8)))short;
using s16x4=__attribute__((ext_vector_type(4)))short;
using f32x16=__attribute__((ext_vector_type(16)))float;
using u32x4=__attribute__((ext_vector_type(4)))unsigned;
constexpr int BATCH=8,NHEAD=16,SEQ=2048,D=64,DM=NHEAD*D;
constexpr int NW=8,QBLK=32,QB=QBLK*NW,KVBLK=64,NQB=SEQ/QB;
constexpr int ATTN_PITCH=DM, ATTN_UNIT_ROWS=QB;
__device__ __forceinline__ int crow(int r,int hi){return (r&3)+8*(r>>2)+4*hi;}
#define SBAR() __builtin_amdgcn_sched_barrier(0)
__device__ __forceinline__ void cmask(f32x16&p0,f32x16&p1,int jb,int qrel,int hi){
  const float NEG=-INFINITY; int kb=64*jb+4*hi;
  #pragma unroll
  for(int r=0;r<16;++r){int kv=kb+(r&3)+8*(r>>2); if(kv>qrel)p0[r]=NEG; if(kv+32>qrel)p1[r]=NEG;}
}

constexpr int NSLOT=3, SLOTB=8192;
constexpr int LDS_K=0, LDS_V=NSLOT*SLOTB, LDS_WS=2*NSLOT*SLOTB, LDS_OST=LDS_WS+NW*64*4, LDS_KB3=LDS_OST+NW*4096, LDS_BYTES=LDS_KB3+SEQ*8;
constexpr float C2=0.125f*1.4426950408889634f;
__device__ __forceinline__ void glds16(const void*gsrc,unsigned lds_dst){unsigned keep;
  asm volatile("s_mov_b32 %0, m0\n\ts_mov_b32 m0, %2\n\ts_nop 0\n\tglobal_load_lds_dwordx4 %1, off\n\ts_mov_b32 m0, %0":"=&s"(keep):"v"(gsrc),"s"(lds_dst):"memory");}
__device__ __forceinline__ float max3f(float a,float b,float c){float r;asm("v_max3_f32 %0, %1, %2, %3":"=v"(r):"v"(a),"v"(b),"v"(c));return r;}
__device__ __forceinline__ float max2f(float a,float b){float r;asm("v_max_f32_e32 %0, %1, %2":"=v"(r):"v"(a),"v"(b));return r;}
__device__ __forceinline__ float fadd_s(float a,float b){float r;asm("v_add_f32_e32 %0, %1, %2":"=v"(r):"v"(a),"v"(b));return r;}
__device__ __forceinline__ float fsub_s(float a,float b){float r;asm("v_sub_f32_e32 %0, %1, %2":"=v"(r):"v"(a),"v"(b));return r;}
typedef unsigned u32x2_t __attribute__((ext_vector_type(2)));
typedef float f32x2_t __attribute__((ext_vector_type(2))); typedef __bf16 bf16x2_t __attribute__((ext_vector_type(2)));
__device__ __forceinline__ unsigned cvtpk_s(float lo,float hi){f32x2_t v={lo,hi};bf16x2_t b=__builtin_convertvector(v,bf16x2_t);return __builtin_bit_cast(unsigned,b);}
#define WAIT_BAR(N) asm volatile("s_waitcnt vmcnt(" #N ") lgkmcnt(0)\n\ts_barrier":::"memory")

__device__ __forceinline__ void qkt(f32x16&p0,f32x16&p1,const char*Kslot,const bf16x8*qr,const f32x16&negm,int r32,int hi,bf16x8 kbA,bf16x8 kbB,bf16x8 ones){
  p0=__builtin_amdgcn_mfma_f32_32x32x16_bf16(kbA,ones,negm,0,0,0);p1=__builtin_amdgcn_mfma_f32_32x32x16_bf16(kbB,ones,negm,0,0,0);
  const char*kb=Kslot+hi*1024+r32*16;
  #pragma unroll
  for(int d0=0;d0<4;++d0){
    const bf16x8 b0=*reinterpret_cast<const bf16x8*>(kb+d0*2048);
    const bf16x8 b1=*reinterpret_cast<const bf16x8*>(kb+d0*2048+512);
    {p0=__builtin_amdgcn_mfma_f32_32x32x16_bf16(b0,qr[d0],p0,0,0,0);p1=__builtin_amdgcn_mfma_f32_32x32x16_bf16(b1,qr[d0],p1,0,0,0);}}
}
typedef __attribute__((address_space(3))) const char* lds_cptr;
typedef short v4i16_t __attribute__((ext_vector_type(4)));
__device__ __forceinline__ void kload8(bf16x8*kf,lds_cptr kp){
  kf[0]=*(const __attribute__((address_space(3))) bf16x8*)(kp);      kf[1]=*(const __attribute__((address_space(3))) bf16x8*)(kp+512);
  kf[2]=*(const __attribute__((address_space(3))) bf16x8*)(kp+2048); kf[3]=*(const __attribute__((address_space(3))) bf16x8*)(kp+2560);
  kf[4]=*(const __attribute__((address_space(3))) bf16x8*)(kp+4096); kf[5]=*(const __attribute__((address_space(3))) bf16x8*)(kp+4608);
  kf[6]=*(const __attribute__((address_space(3))) bf16x8*)(kp+6144); kf[7]=*(const __attribute__((address_space(3))) bf16x8*)(kp+6656);
}
__device__ __forceinline__ void kload2(bf16x8*kf,lds_cptr kp,int j){ kf[2*j]=*(const __attribute__((address_space(3))) bf16x8*)(kp+j*2048); kf[2*j+1]=*(const __attribute__((address_space(3))) bf16x8*)(kp+j*2048+512); }
__device__ __forceinline__ s16x4 vtr(lds_cptr p){ return __builtin_bit_cast(s16x4,__builtin_amdgcn_ds_read_tr16_b64_v4i16((__attribute__((address_space(3))) v4i16_t*)p)); }
__device__ __forceinline__ float rowmax(const f32x16&p0,const f32x16&p1){
  float a=max3f(p0[0],p0[1],p1[0]),b=max3f(p0[2],p0[3],p1[1]);a=max3f(a,p1[2],p1[3]);
  #pragma unroll
  for(int r=4;r<16;r+=4){a=max3f(a,p0[r],p0[r+1]);b=max3f(b,p0[r+2],p0[r+3]);a=max3f(a,p1[r],p1[r+1]);b=max3f(b,p1[r+2],p1[r+3]);}
  const float m=max2f(a,b);
  auto rr=__builtin_amdgcn_permlane32_swap(__float_as_uint(m),__float_as_uint(m),false,false);
  return max2f(__uint_as_float(rr[0]),__uint_as_float(rr[1]));
}
__device__ __forceinline__ void pv(f32x16*o,int vb,bf16x8 pa0,bf16x8 pa1,bf16x8 pa2,bf16x8 pa3){
  #pragma unroll
  for(int d0=0;d0<2;++d0){s16x4 lo[4],hi[4];
    #pragma unroll
    for(int ks=0;ks<4;++ks){
      asm volatile("ds_read_b64_tr_b16 %0,%1 offset:%c2":"=&v"(lo[ks]):"v"(vb),"i"(d0*4096+ks*1024):"memory");
      asm volatile("ds_read_b64_tr_b16 %0,%1 offset:%c2":"=&v"(hi[ks]):"v"(vb),"i"(d0*4096+ks*1024+512):"memory");}
    asm volatile("s_waitcnt lgkmcnt(0)":::"memory");SBAR();
    #define PK(k) (bf16x8){lo[k][0],lo[k][1],lo[k][2],lo[k][3],hi[k][0],hi[k][1],hi[k][2],hi[k][3]}
    o[d0]=__builtin_amdgcn_mfma_f32_32x32x16_bf16(pa0,PK(0),o[d0],0,0,0);
    o[d0]=__builtin_amdgcn_mfma_f32_32x32x16_bf16(pa1,PK(1),o[d0],0,0,0);
    o[d0]=__builtin_amdgcn_mfma_f32_32x32x16_bf16(pa2,PK(2),o[d0],0,0,0);
    o[d0]=__builtin_amdgcn_mfma_f32_32x32x16_bf16(pa3,PK(3),o[d0],0,0,0);
    #undef PK
  }
}

#ifndef ATTN_STORE16
#define ATTN_STORE16(p,v) (*(u32x4*)(p)=(v))
#endif
template<int THRL> __device__ __forceinline__ void attn_unit(int b,int h,int qb,const bf16*Q,const bf16*__restrict__ K,const bf16*__restrict__ V,bf16*O,const bf16*__restrict__ Gt,const float*__restrict__ LOGF,const float qkbound,const int reuse,char*shm,const int tid_in){
  const int tid=tid_in,lane=tid&63,r32=lane&31,hi=lane>>5; const int wid=__builtin_amdgcn_readfirstlane(tid>>6);
  const long rowbase=(long)b*SEQ; const int q0=qb*QB;
  const bf16*Qw=Q+(rowbase+q0+wid*QBLK)*DM+h*D;
  const bf16*Kh=K+rowbase*DM+h*D,*Vh=V+rowbase*DM+h*D;
  const unsigned lds0=(unsigned)(uintptr_t)shm;
  float*wsf=(float*)(shm+LDS_WS)+wid*64;
  const bf16*ksrc0_=Kh+(long)lane*DM+wid*8;
  const bf16*vsrc0_=Vh+(long)(16*(wid&3)+(lane>>2))*DM+(wid>>2)*32+(lane&3)*8;
  const unsigned kdst=lds0+LDS_K+wid*1024, vdst=lds0+LDS_V+wid*1024;
  #define DMA_K(t,slot) glds16(ksrc+(long)(t)*KVBLK*DM,(unsigned)__builtin_amdgcn_readfirstlane(kdst+(slot)))
  #define DMA_V(t,slot) glds16(vsrc+(long)(t)*KVBLK*DM,(unsigned)__builtin_amdgcn_readfirstlane(vdst+(slot)))
  const int vb0=(int)(lds0+LDS_V)+((lane>>4)&1)*32+(lane&3)*8+(4*hi+((lane&15)>>2))*64;
  const char*Kbase=shm+LDS_K; bf16x8 kf[8];
  const lds_cptr shm3=(lds_cptr)shm; const lds_cptr kp0=shm3+LDS_K+hi*1024+r32*16; const lds_cptr vp0=shm3+LDS_V+((lane>>4)&1)*32+(lane&3)*8+(4*hi+((lane&15)>>2))*64;
  const int NT0_=(q0+QB)/KVBLK;
  int t0_=0;
  if(!reuse){
    typedef float f32x4_a __attribute__((ext_vector_type(4))); const int nk=q0+QB; int tl_=tid; asm volatile("":"+v"(tl_));     const f32x4_a x4=(4*tid<nk)?*(const f32x4_a*)(LOGF+(long)(b*NHEAD+h)*SEQ+4*tl_):(f32x4_a){0.f,0.f,0.f,0.f};
    const float p0_=x4[0],p1_=p0_+x4[1],p2_=p1_+x4[2],p3_=p2_+x4[3]; float incl=p3_;
    #pragma unroll
    for(int off=1;off<64;off<<=1){const float t_=__uint_as_float((unsigned)__builtin_amdgcn_ds_bpermute(4*(lane-off),(int)__float_as_uint(incl))); if(lane>=off)incl+=t_;}
    __attribute__((address_space(3))) float*wsum=(__attribute__((address_space(3))) float*)(shm3+LDS_WS);
    if(lane==63)wsum[wid]=incl;
    asm volatile("s_waitcnt vmcnt(0) lgkmcnt(0)\n\ts_barrier":::"memory");
    float basec=incl-p3_;
    #pragma unroll
    for(int w_=0;w_<NW-1;++w_){const float ws_=wsum[w_]; if(w_<wid)basec+=ws_;}
    if(4*tid<nk){ const float L2E=1.4426950408889634f; unsigned long long e_[4]; const float pc_[4]={p0_,p1_,p2_,p3_};
      #pragma unroll
      for(int k_=0;k_<4;++k_){ const float v_=-(basec+pc_[k_])*L2E; const unsigned h_=__builtin_bit_cast(unsigned,__builtin_bit_cast(unsigned,v_));
        const unsigned hb_=(h_+0x7fffu+((h_>>16)&1u))>>16; const float r1_=v_-__uint_as_float(hb_<<16); const unsigned m1_=__builtin_bit_cast(unsigned,r1_); const unsigned mb_=(m1_+0x7fffu+((m1_>>16)&1u))>>16;
        const float r2_=r1_-__uint_as_float(mb_<<16); const unsigned l1_=__builtin_bit_cast(unsigned,r2_); const unsigned lb_=(l1_+0x7fffu+((l1_>>16)&1u))>>16;
        e_[k_]=(unsigned long long)hb_|((unsigned long long)mb_<<16)|((unsigned long long)lb_<<32)|(0x3F80ull<<48); }
      *(__attribute__((address_space(3))) u32x4*)(shm3+LDS_KB3+32*tid)=(u32x4){(unsigned)e_[0],(unsigned)(e_[0]>>32),(unsigned)e_[1],(unsigned)(e_[1]>>32)};
      *(__attribute__((address_space(3))) u32x4*)(shm3+LDS_KB3+32*tid+16)=(u32x4){(unsigned)e_[2],(unsigned)(e_[2]>>32),(unsigned)e_[3],(unsigned)(e_[3]>>32)};
 }
    asm volatile("s_waitcnt lgkmcnt(0)\n\ts_barrier":::"memory"); }
  {
    { int j_=lane; asm volatile("":"+v"(j_));     const u32x2_t ej_=*(const __attribute__((address_space(3))) u32x2_t*)(shm3+LDS_KB3+(64*(j_&31)+63)*8), eq_=*(const __attribute__((address_space(3))) u32x2_t*)(shm3+LDS_KB3+q0*8);
      const float vj_=(__uint_as_float(ej_[0]<<16)+__uint_as_float(ej_[0]&0xffff0000u))+__uint_as_float(ej_[1]<<16), vq_=(__uint_as_float(eq_[0]<<16)+__uint_as_float(eq_[0]&0xffff0000u))+__uint_as_float(eq_[1]<<16);
      const bool sk_=(j_<NT0_-4)&&((vj_-vq_)+qkbound<-152.0f);
      const unsigned long long m_=__builtin_amdgcn_ballot_w64(sk_);
      t0_=(int)__builtin_amdgcn_readfirstlane((int)__builtin_ctzll(~m_))&~1; } }
  const int NT=NT0_-t0_; const bf16*ksrc=ksrc0_+(long)t0_*KVBLK*DM; const bf16*vsrc=vsrc0_+(long)t0_*KVBLK*DM;
  const lds_cptr kbl3=shm3+LDS_KB3+t0_*KVBLK*8;
  asm volatile("s_waitcnt vmcnt(0)":::"memory");
  bf16x8 ones;
  #define KBLOAD(t,FA,FB) bf16x8 FA,FB; { const lds_cptr kbp_=kbl3+((t)*KVBLK+r32)*8; \
      u32x2_t wa_=*(const __attribute__((address_space(3))) u32x2_t*)(kbp_), wb_=*(const __attribute__((address_space(3))) u32x2_t*)(kbp_+256); \
      if(hi){wa_=(u32x2_t){0u,0u};wb_=(u32x2_t){0u,0u};} \
      FA=__builtin_bit_cast(bf16x8,(u32x4){wa_[0],wa_[1],hi?0u:0x3F803F80u,0u}); FB=__builtin_bit_cast(bf16x8,(u32x4){wb_[0],wb_[1],hi?0u:0x3F803F80u,0u}); }
  DMA_K(0,0);DMA_V(0,0);DMA_K(1,SLOTB);
  bf16x8 qr[4];
  #pragma unroll
  for(int d0=0;d0<4;++d0)qr[d0]=*reinterpret_cast<const bf16x8*>(&Qw[(long)r32*DM+d0*16+hi*8]);
  float zero_; asm volatile("v_mov_b32 %0, 0":"=v"(zero_));
  float mhat=0.f,l_reg=0.f;f32x16 o[2];f32x16 negm;
  _Pragma("unroll") for(int r=0;r<16;++r){o[0][r]=zero_;o[1][r]=zero_;negm[r]=zero_;} asm volatile("":"+v"(negm));
  const int qrel=wid*QBLK+r32;
  #define CMASK(P0,P1,t) do{int jb_=(t)-(NT-4); if(jb_>=0)cmask(P0,P1,jb_,qrel,hi);}while(0)
  bool resc=false;
  #define START(P0,P1) do{ const float rm=rowmax(P0,P1); resc=false; \
    { const float dl=__builtin_fmaxf(rm,0.f); mhat=fadd_s(mhat,dl);     \
      _Pragma("unroll") for(int r=0;r<16;++r){P0[r]=fsub_s(P0[r],dl);P1[r]=fsub_s(P1[r],dl);} \
      _Pragma("unroll") for(int r=0;r<16;++r)negm[r]=-mhat; asm volatile("":"+v"(negm)); } \
    _Pragma("unroll") for(int r=0;r<16;++r)P0[r]=__builtin_amdgcn_exp2f(P0[r]); }while(0)
  #define RESC() do{ if(resc){ asm volatile("s_waitcnt lgkmcnt(0)":::"memory"); \
      _Pragma("unroll") for(int d_=0;d_<2;++d_) _Pragma("unroll") for(int r=0;r<16;++r)o[d_][r]*=wsf[crow(r,hi)]; } }while(0)
  f32x16 pA0,pA1,pB0,pB1;
  int sl_prev=0,sl_cur=0,sl_next=SLOTB;
  #define ROT() do{sl_prev=sl_cur;sl_cur=sl_next;sl_next=(sl_next==(NSLOT-1)*SLOTB)?0:sl_next+SLOTB;}while(0)
  DMA_K(2,2*SLOTB);
  WAIT_BAR(3);
  { const u32x2_t wq_=*(const __attribute__((address_space(3))) u32x2_t*)(shm3+LDS_KB3+(q0+wid*QBLK+r32)*8);
    ones=__builtin_bit_cast(bf16x8,(u32x4){hi?0u:0x3F803F80u, hi?0u:(0x3F80u|(((wq_[0]&0xffffu)^0x8000u)<<16)), hi?0u:(((wq_[0]>>16)^0x8000u)|(((wq_[1]&0xffffu)^0x8000u)<<16)), 0u}); }
  { KBLOAD(0,kbA0_,kbB0_); qkt(pA0,pA1,Kbase,qr,negm,r32,hi,kbA0_,kbB0_,ones); } asm volatile("s_nop 15\n\ts_nop 7":"+v"(pA0),"+v"(pA1));CMASK(pA0,pA1,0);
  START(pA0,pA1);
  _Pragma("unroll") for(int r=0;r<16;++r)pA1[r]=__builtin_amdgcn_exp2f(pA1[r]);
  WAIT_BAR(0);
  DMA_K(3,0);DMA_V(1,SLOTB);
  ROT();
  kload8(kf,kp0+sl_cur);
  WAIT_BAR(2);
  s16x4 vlo[8],vhi[8]; u32x4 pw0,pw1,pw2,pw3;
  #define PKW(P,B) cvtpk_s(P[B],P[B+1])
  #define PAF(k) __builtin_bit_cast(bf16x8,pw##k)
  #define VFR(i) (bf16x8){vlo[i][0],vlo[i][1],vlo[i][2],vlo[i][3],vhi[i][0],vhi[i][1],vhi[i][2],vhi[i][3]}
  #define PIN(x) asm volatile("":"+v"(x))
  #define MX3(a,b,c) __builtin_fmaxf(__builtin_fmaxf((a),(b)),(c))
  #define GAPA(MF,A0,A1,A2,A3,W0,W1,PW) do{ MF; sacc+=A0; sacc+=A1; sacc+=A2; sacc+=A3; PIN(sacc); W0; W1; PIN(PW); SBAR(); }while(0)
  #define EX(v) __builtin_amdgcn_exp2f(v)
  #define GAPB(MF,X,B) do{ MF; X[B]=EX(X[B]); X[B+1]=EX(X[B+1]); X[B+2]=EX(X[B+2]); X[B+3]=EX(X[B+3]); PIN(X); SBAR(); }while(0)
  #define VRD(i) do{ vlo[i]=vtr(vp_+(((i)>>2)*4096+((i)&3)*1024)); vhi[i]=vtr(vp_+(((i)>>2)*4096+((i)&3)*1024+512)); }while(0)
  #define KRD(G,j) do{ if(G){ kload2(kf,kp0+sl_next,j); SBAR(); } }while(0)
  #define STEP(C0,C1,P0,P1,t,GK,GV,GL) do{ SBAR(); \
    { KBLOAD(t,kbA_,kbB_); C0=__builtin_amdgcn_mfma_f32_32x32x16_bf16(kbA_,ones,negm,0,0,0); C1=__builtin_amdgcn_mfma_f32_32x32x16_bf16(kbB_,ones,negm,0,0,0); } SBAR(); \
    const lds_cptr vp_=vp0+sl_prev; \
    VRD(0); SBAR(); float sacc=(P0[0]+P0[1]); \
    GAPA(C0=__builtin_amdgcn_mfma_f32_32x32x16_bf16(kf[0],qr[0],C0,0,0,0), P0[2],P0[3],P0[4],P0[5],     pw0[0]=PKW(P0,0), pw0[1]=PKW(P0,2), pw0); \
    VRD(4); SBAR(); GAPA(C1=__builtin_amdgcn_mfma_f32_32x32x16_bf16(kf[1],qr[0],C1,0,0,0), P0[6],P0[7],P0[8],P0[9],     pw0[2]=PKW(P0,4), pw0[3]=PKW(P0,6), pw0); \
    VRD(1); SBAR(); GAPA(C0=__builtin_amdgcn_mfma_f32_32x32x16_bf16(kf[2],qr[1],C0,0,0,0),   P0[10],P0[11],P0[12],P0[13], pw1[0]=PKW(P0,8), pw1[1]=PKW(P0,10), pw1); \
    VRD(5); SBAR(); GAPA(C1=__builtin_amdgcn_mfma_f32_32x32x16_bf16(kf[3],qr[1],C1,0,0,0),   P0[14],P0[15],P1[0],P1[1],   pw1[2]=PKW(P0,12),pw1[3]=PKW(P0,14), pw1); \
    VRD(2); SBAR(); GAPA(C0=__builtin_amdgcn_mfma_f32_32x32x16_bf16(kf[4],qr[2],C0,0,0,0),   P1[2],P1[3],P1[4],P1[5],     pw2[0]=PKW(P1,0), pw2[1]=PKW(P1,2), pw2); \
    VRD(6); SBAR(); GAPA(C1=__builtin_amdgcn_mfma_f32_32x32x16_bf16(kf[5],qr[2],C1,0,0,0),   P1[6],P1[7],P1[8],P1[9],     pw2[2]=PKW(P1,4), pw2[3]=PKW(P1,6), pw2); \
    VRD(3); SBAR(); GAPA(C0=__builtin_amdgcn_mfma_f32_32x32x16_bf16(kf[6],qr[3],C0,0,0,0),   P1[10],P1[11],P1[12],P1[13], pw3[0]=PKW(P1,8), pw3[1]=PKW(P1,10), pw3); \
    VRD(7); SBAR(); GAPA(C1=__builtin_amdgcn_mfma_f32_32x32x16_bf16(kf[7],qr[3],C1,0,0,0),   P1[14],P1[15],0.f,0.f,       pw3[2]=PKW(P1,12),pw3[3]=PKW(P1,14), pw3); \
    l_reg+=sacc; \
    if(GK){DMA_K((t)+3,sl_cur);} if(GV){DMA_V((t)+1,sl_next);} \
    CMASK(C0,C1,t); \
    { float a=MX3(C0[0],C0[1],C1[0]),b=MX3(C0[2],C0[3],C1[1]); a=MX3(a,C1[2],C1[3]); \
      _Pragma("unroll") for(int r=4;r<16;r+=4){a=MX3(a,C0[r],C0[r+1]);b=MX3(b,C0[r+2],C0[r+3]);a=MX3(a,C1[r],C1[r+1]);b=MX3(b,C1[r+2],C1[r+3]);} \
      float rm=__builtin_fmaxf(a,b); { auto rr=__builtin_amdgcn_permlane32_swap(__float_as_uint(rm),__float_as_uint(rm),false,false); rm=__builtin_fmaxf(__uint_as_float(rr[0]),__uint_as_float(rr[1])); } \
      resc=false; \
      if(__builtin_expect(__any(rm>(float)THRL),0)){ const float dl=__builtin_fmaxf(rm,0.f); mhat+=dl; \
        _Pragma("unroll") for(int r=0;r<16;++r){C0[r]-=dl;C1[r]-=dl;} \
        _Pragma("unroll") for(int r=0;r<16;++r)negm[r]=-mhat; asm volatile("":"+v"(negm)); \
        const float f=__builtin_amdgcn_exp2f(-dl); l_reg*=f; if(hi==0)wsf[r32]=f; resc=true; } } \
    SBAR(); \
    GAPB(o[0]=__builtin_amdgcn_mfma_f32_32x32x16_bf16(PAF(0),VFR(0),o[0],0,0,0), C0,0); \
    GAPB(o[1]=__builtin_amdgcn_mfma_f32_32x32x16_bf16(PAF(0),VFR(4),o[1],0,0,0), C0,4); \
    KRD(GL,0); GAPB(o[0]=__builtin_amdgcn_mfma_f32_32x32x16_bf16(PAF(1),VFR(1),o[0],0,0,0), C0,8); \
    KRD(GL,1); GAPB(o[1]=__builtin_amdgcn_mfma_f32_32x32x16_bf16(PAF(1),VFR(5),o[1],0,0,0), C0,12); \
    KRD(GL,2); GAPB(o[0]=__builtin_amdgcn_mfma_f32_32x32x16_bf16(PAF(2),VFR(2),o[0],0,0,0), C1,0); \
    KRD(GL,3); GAPB(o[1]=__builtin_amdgcn_mfma_f32_32x32x16_bf16(PAF(2),VFR(6),o[1],0,0,0), C1,4); \
    GAPB(o[0]=__builtin_amdgcn_mfma_f32_32x32x16_bf16(PAF(3),VFR(3),o[0],0,0,0), C1,8); \
    GAPB(o[1]=__builtin_amdgcn_mfma_f32_32x32x16_bf16(PAF(3),VFR(7),o[1],0,0,0), C1,12); \
    }while(0)
  int t=1;
  #undef CMASK
  #define CMASK(P0,P1,t) do{}while(0)
  for(;t+5<NT;t+=2){
    STEP(pB0,pB1,pA0,pA1,t,true,true,true);     WAIT_BAR(2); RESC(); ROT();
    STEP(pA0,pA1,pB0,pB1,t+1,true,true,true);   WAIT_BAR(2); RESC(); ROT();
  }
  #undef CMASK
  #define CMASK(P0,P1,t) do{int jb_=(t)-(NT-4); if(jb_>=0)cmask(P0,P1,jb_,qrel,hi);}while(0)
  #define ENDW(tt) do{ if((tt)+3<NT){WAIT_BAR(2);} else if((tt)+2<NT){WAIT_BAR(1);} else {WAIT_BAR(0);} }while(0)
  for(;t+1<NT;t+=2){
    STEP(pB0,pB1,pA0,pA1,t,(t+3<NT),(t+1<NT),(t+1<NT));       ENDW(t);   RESC(); ROT();
    STEP(pA0,pA1,pB0,pB1,t+1,(t+4<NT),(t+2<NT),(t+2<NT));     ENDW(t+1); RESC(); ROT();
  }
  STEP(pB0,pB1,pA0,pA1,NT-1,false,false,false); RESC();
  { float sacc=pB0[0]+pB0[1]; _Pragma("unroll") for(int r=2;r<16;++r)sacc+=pB0[r]; _Pragma("unroll") for(int r=0;r<16;++r)sacc+=pB1[r]; l_reg+=sacc;
    pw0=(u32x4){PKW(pB0,0),PKW(pB0,2),PKW(pB0,4),PKW(pB0,6)};pw1=(u32x4){PKW(pB0,8),PKW(pB0,10),PKW(pB0,12),PKW(pB0,14)};pw2=(u32x4){PKW(pB1,0),PKW(pB1,2),PKW(pB1,4),PKW(pB1,6)};pw3=(u32x4){PKW(pB1,8),PKW(pB1,10),PKW(pB1,12),PKW(pB1,14)};
    SBAR(); pv(o,vb0+sl_cur,PAF(0),PAF(1),PAF(2),PAF(3)); }
  #undef PKW
  #undef PAF
  #undef VFR
  #undef PIN
  #undef MX3
  #undef GAPA
  #undef GAPB
  #undef EX
  #undef VRD
  #undef KRD
  #undef STEP
  #undef ENDW
  {auto rr=__builtin_amdgcn_permlane32_swap(__float_as_uint(l_reg),__float_as_uint(l_reg),false,false);l_reg=__uint_as_float(rr[0])+__uint_as_float(rr[1]);}
  if(hi==0)wsf[32+r32]=l_reg;asm volatile("s_waitcnt lgkmcnt(0)":::"memory");
  float rli[16];
  #pragma unroll
  for(int r=0;r<16;++r)rli[r]=__builtin_amdgcn_rcpf(wsf[32+crow(r,hi)]);
  bf16*Ow=O+(rowbase+q0+wid*QBLK)*DM+h*D; const bf16*Gw=Gt+(rowbase+q0+wid*QBLK)*DM+h*D;
  u32x4 gv[4];
  #pragma unroll
  for(int i=0;i<4;++i){const int row=i*8+(lane>>3),ch=lane&7; gv[i]=*(const u32x4*)(Gw+(long)row*DM+ch*8);}
  { bf16*stg=(bf16*)(shm+LDS_OST)+wid*2048;
    #pragma unroll
    for(int r=0;r<16;++r){const int orow=crow(r,hi);
      #pragma unroll
      for(int d0=0;d0<2;++d0)stg[orow*64+d0*32+r32]=__float2bfloat16(o[d0][r]*rli[r]);}
    asm volatile("s_waitcnt lgkmcnt(0)":::"memory");
    #pragma unroll
    for(int i=0;i<4;++i){const int row=i*8+(lane>>3),ch=lane&7; u32x4 v=*(const u32x4*)(stg+row*64+ch*8);
      #pragma unroll
      for(int w=0;w<4;++w){ const float olo=__uint_as_float(v[w]<<16), ohi=__uint_as_float(v[w]&0xffff0000u), glo=__uint_as_float(gv[i][w]<<16), ghi=__uint_as_float(gv[i][w]&0xffff0000u);
        const float slo=__builtin_amdgcn_rcpf(1.0f+__builtin_amdgcn_exp2f(-1.4426950408889634f*glo)), shi=__builtin_amdgcn_rcpf(1.0f+__builtin_amdgcn_exp2f(-1.4426950408889634f*ghi));
        v[w]=cvtpk_s(olo*slo,ohi*shi); }
      ATTN_STORE16(Ow+(long)row*DM+ch*8,v);} }
  asm volatile("s_waitcnt lgkmcnt(0)\n\ts_barrier":::"memory");
  #undef KBLOAD
  #undef DMA_K
  #undef DMA_V
  #undef CMASK
  #undef START
  #undef RESC
  #undef ROT
}
constexpr int ATTN_LDS_BYTES=LDS_BYTES;
struct AttnTensors { const bf16* Q; const bf16* K; const bf16* V; bf16* O; const bf16* G; const float* LOGF; float qkbound; };
struct AttnUnit { int bh; int qb; int reuse; };
struct StaticOrder {
  int vcu, grid;
  __device__ __forceinline__ explicit StaticOrder(int grid_,int vcu_):vcu(vcu_),grid(grid_){}
  __device__ __forceinline__ bool next(int i,AttnUnit&u)const{ const int p=vcu+(i>>1)*grid; if(p>=BATCH*NHEAD*4)return false; const int q=(p&31)+32*(p>>8), s=(q<32)?(q&3):(3-(q&3)); u.bh=((p>>5)&7)*NHEAD+((q<32)?(q>>2):(NHEAD-1-((q-32)>>2)));     u.qb=(i&1)?s:(NQB-1-s); u.reuse=i&1; return true; }
  __device__ __forceinline__ void a_ready(const AttnUnit&)const{}
  __device__ __forceinline__ void done(const AttnUnit&)const{}
};
template<class Sched,int THRL=8> __device__ __forceinline__ void attn_phase(char*lds,const AttnTensors&T,const Sched&S,const int tid_in){
  AttnUnit u;
  for(int i=0;S.next(i,u);++i){ S.a_ready(u); { const long bo_=(long)(u.bh/NHEAD)*3*SEQ*DM;     attn_unit<THRL>(u.bh/NHEAD,u.bh%NHEAD,u.qb,T.Q+bo_,T.K+bo_,T.V+bo_,T.O+bo_,T.G+bo_,T.LOGF,T.qkbound,u.reuse,lds,tid_in); } S.done(u); }
}
#undef SBAR
#undef WAIT_BAR
}
namespace cg = cooperative_groups;
constexpr int NWAVES = 8;
constexpr int BATCH = 8, SEQ = 2048, D = 1024, M = BATCH * SEQ, FF = 4096, GE = 2048, FOXN = 4112, NPHASES = 21;
constexpr float RMS_EPS = 1e-6f, LN_EPS = 1e-5f;
constexpr size_t MiB = 1u << 20;
constexpr size_t WS_CTL = 0, WS_STATS = 1 * MiB  , WS_LOGF = 6 * MiB  ;
constexpr size_t WS_WF = 512 * 1024  , WS_XS = 5 * MiB  ;
constexpr size_t WS_WIN_G = 8 * MiB, WS_WOUT_G = 24 * MiB, WS_WIN_F = 32 * MiB, WS_WOUT_F = 48 * MiB, WS_W1 = 52 * MiB, WS_W2 = 84 * MiB;
constexpr size_t WS_XN = 116 * MiB, WS_BIG = 148 * MiB, WS_END = 276 * MiB;
constexpr int LDS_BYTES = 147456;
static_assert(attn_body::ATTN_LDS_BYTES <= 131072, "attention LDS");
#define LAS __attribute__((address_space(3)))
typedef unsigned short bf16;
typedef unsigned v4u __attribute__((ext_vector_type(4)));
typedef unsigned v2u __attribute__((ext_vector_type(2)));
typedef float f32x4 __attribute__((ext_vector_type(4)));
typedef short bf16x8 __attribute__((ext_vector_type(8)));
__device__ __forceinline__ unsigned f2bf(float f) { unsigned u = __builtin_bit_cast(unsigned, f); return (u + 0x7fffu + ((u >> 16) & 1u)) >> 16; }
__device__ __forceinline__ unsigned pk2(float lo, float hi) { return f2bf(lo) | (f2bf(hi) << 16); }
__device__ __forceinline__ float bflo(unsigned w) { return __uint_as_float(w << 16); }
__device__ __forceinline__ float bfhi(unsigned w) { return __uint_as_float(w & 0xffff0000u); }
__device__ __forceinline__ float wave_sum(float v) {
#pragma unroll
    for (int o = 1; o < 64; o <<= 1) v += __shfl_xor(v, o);
    return v;
}
typedef __attribute__((address_space(4))) const unsigned char* kptr_t;
struct Frame { LAS unsigned char* lds; int tid, lane, wave, vcu, cid, G; kptr_t kp; };
#define KIN(F_, i) (*(const float* const __attribute__((address_space(4)))*)((F_).kp + 8 * (i)))
#define KOUT(F_) (*(float* const __attribute__((address_space(4)))*)((F_).kp + 128))
#define KWS(F_) (*(unsigned char* const __attribute__((address_space(4)))*)((F_).kp + 136))
__device__ __forceinline__ bool relaunder(Frame& F) { int m1 = -1; asm volatile("" : "+s"(m1)); const int ln = __builtin_amdgcn_mbcnt_hi(m1, __builtin_amdgcn_mbcnt_lo(m1, 0));
    { kptr_t k = F.kp; asm volatile("" : "+s"(k)); F.kp = k; } F.lane = ln; F.tid = F.wave * 64 + ln; return true; }

struct P0Item { const float* W; bf16* WT; const float* gain; int ldw, K, N, item; };
__device__ __forceinline__ P0Item p0_decode(const Frame& F, unsigned char* ws, int it) {
    constexpr int I_WIN = (D / 64) * (4096 / 32), I_WOG = (GE / 64) * (D / 32), I_WOF = (D / 64) * (D / 32), I_W2 = (FF / 64) * (D / 32);
    P0Item q; int r = it;
    constexpr int PER_J = I_WIN + I_WOG + I_WIN + I_WOF;
    if (r < 2 * PER_J) { const int j = r / PER_J; r -= j * PER_J;
        if (r < I_WIN) { q = P0Item{KIN(F, 1) + (size_t)j * D * 4096, (bf16*)(ws + WS_WIN_G + j * 8 * MiB), KIN(F, 12) + (2 * j) * D, 4096, D, 4096, r}; return q; } r -= I_WIN;
        if (r < I_WOG) { q = P0Item{KIN(F, 6) + (size_t)j * GE * D, (bf16*)(ws + WS_WOUT_G + j * 4 * MiB), nullptr, D, GE, D, r}; return q; } r -= I_WOG;
        if (r < I_WIN) { q = P0Item{KIN(F, 7) + (size_t)j * D * FOXN, (bf16*)(ws + WS_WIN_F + j * 8 * MiB), KIN(F, 12) + (2 * j + 1) * D, FOXN, D, 4096, r}; return q; } r -= I_WIN;
        q = P0Item{KIN(F, 11) + (size_t)j * D * D, (bf16*)(ws + WS_WOUT_F + j * 2 * MiB), nullptr, D, D, D, r}; return q; }
    r -= 2 * PER_J; { const int i = r / (I_WIN + I_W2); r -= i * (I_WIN + I_W2);
        if (r < I_WIN) { q = P0Item{KIN(F, 14) + (size_t)i * D * FF, (bf16*)(ws + WS_W1 + i * 8 * MiB), KIN(F, 13) + i * D, FF, D, FF, r}; return q; } r -= I_WIN;
        q = P0Item{KIN(F, 15) + (size_t)i * FF * D, (bf16*)(ws + WS_W2 + i * 8 * MiB), nullptr, D, FF, D, r}; return q; }
}
__device__ __forceinline__ void p0_load(const P0Item& q, int lane, f32x4 (&v)[8]) {
    const int nblk = q.N / 32, kb = q.item / nblk, nb = q.item % nblk, k0 = 64 * kb, n0 = 32 * nb, c = lane & 7, n4 = lane >> 3;
    const float* src = q.W + (size_t)(k0 + 8 * c) * q.ldw + n0 + 4 * n4;
#pragma unroll
    for (int i = 0; i < 8; ++i) v[i] = __builtin_nontemporal_load((const f32x4*)(src + (size_t)i * q.ldw));
}
__device__ __forceinline__ void p0_store(const P0Item& q, int lane, f32x4 (&v)[8]) {
    const int nblk = q.N / 32, kb = q.item / nblk, nb = q.item % nblk, k0 = 64 * kb, n0 = 32 * nb, c = lane & 7, n4 = lane >> 3;
    if (q.gain) { const f32x4 g0 = *(const f32x4*)(q.gain + k0 + 8 * c), g1 = *(const f32x4*)(q.gain + k0 + 8 * c + 4);
        v[0] = v[0] * g0.x; v[1] = v[1] * g0.y; v[2] = v[2] * g0.z; v[3] = v[3] * g0.w; v[4] = v[4] * g1.x; v[5] = v[5] * g1.y; v[6] = v[6] * g1.z; v[7] = v[7] * g1.w; }
#pragma unroll
    for (int e = 0; e < 4; ++e) { v4u o; o.x = pk2(v[0][e], v[1][e]); o.y = pk2(v[2][e], v[3][e]); o.z = pk2(v[4][e], v[5][e]); o.w = pk2(v[6][e], v[7][e]);
        __builtin_nontemporal_store(o, (v4u*)(q.WT + (size_t)(n0 + 4 * n4 + e) * q.K + k0 + 8 * c)); }
}
__device__ __forceinline__ void p0_prologue(const Frame& F, unsigned char* ws) {
    const int gw = F.vcu * NWAVES + F.wave, NGW = F.G * NWAVES;
    constexpr int I_WIN = (D / 64) * (4096 / 32), I_WOG = (GE / 64) * (D / 32), I_WOF = (D / 64) * (D / 32), I_W2 = (FF / 64) * (D / 32);
    constexpr int NITEMS = 2 * (I_WIN + I_WOG + I_WIN + I_WOF) + 4 * (I_WIN + I_W2);
    for (int it = gw; it < NITEMS; it += 4 * NGW) {
        const bool h1 = it + NGW < NITEMS, h2 = it + 2 * NGW < NITEMS, h3 = it + 3 * NGW < NITEMS;
        const P0Item a = p0_decode(F, ws, it), b = p0_decode(F, ws, h1 ? it + NGW : it), c = p0_decode(F, ws, h2 ? it + 2 * NGW : it), d = p0_decode(F, ws, h3 ? it + 3 * NGW : it);
        f32x4 va[8], vb[8], vc[8], vd[8]; p0_load(a, F.lane, va); p0_load(b, F.lane, vb); p0_load(c, F.lane, vc); p0_load(d, F.lane, vd);
        p0_store(a, F.lane, va); if (h1) p0_store(b, F.lane, vb); if (h2) p0_store(c, F.lane, vc); if (h3) p0_store(d, F.lane, vd);
    }
}
__device__ __forceinline__ void p0_rows(const Frame& F, unsigned char* ws) {
    const int gw = F.vcu * NWAVES + F.wave, NGW = F.G * NWAVES;
    bf16* XN = (bf16*)(ws + WS_XN); float* xs = (float*)(ws + WS_XS);
    for (int m = gw; m < M; m += 2 * NGW) {
        const int m2 = (m + NGW < M) ? m + NGW : m;
        const f32x4* xa = (const f32x4*)(KIN(F, 0) + (size_t)m * D) + F.lane; const f32x4* xb = (const f32x4*)(KIN(F, 0) + (size_t)m2 * D) + F.lane;
        f32x4 v[4], w[4]; float sa = 0.f, sb = 0.f;
#pragma unroll
        for (int j = 0; j < 4; ++j) { v[j] = __builtin_nontemporal_load(xa + 64 * j); w[j] = __builtin_nontemporal_load(xb + 64 * j); }
#pragma unroll
        for (int j = 0; j < 4; ++j) { sa += (v[j].x * v[j].x + v[j].y * v[j].y) + (v[j].z * v[j].z + v[j].w * v[j].w); sb += (w[j].x * w[j].x + w[j].y * w[j].y) + (w[j].z * w[j].z + w[j].w * w[j].w); }
        sa = wave_sum(sa); sb = wave_sum(sb);
        unsigned long long* oa = (unsigned long long*)(XN + (size_t)m * D) + F.lane; unsigned long long* ob = (unsigned long long*)(XN + (size_t)m2 * D) + F.lane;
#pragma unroll
        for (int j = 0; j < 4; ++j) { oa[64 * j] = (unsigned long long)pk2(v[j].x, v[j].y) | ((unsigned long long)pk2(v[j].z, v[j].w) << 32); ob[64 * j] = (unsigned long long)pk2(w[j].x, w[j].y) | ((unsigned long long)pk2(w[j].z, w[j].w) << 32); }
        if (F.lane == 0) { *(f32x4*)(xs + (size_t)m * 4) = (f32x4){sa, 0.f, 0.f, 0.f}; *(f32x4*)(xs + (size_t)m2 * 4) = (f32x4){sb, 0.f, 0.f, 0.f}; }
    }
    for (int i = blockIdx.x * (NWAVES * 64) + F.tid; i < 2 * 16 * 1024; i += F.G * NWAVES * 64) { const int j = i >> 14, h = (i >> 10) & 15, k = i & 1023;
        ((bf16*)(ws + WS_WF))[i] = (bf16)f2bf(KIN(F, 7)[(size_t)j * D * FOXN + (size_t)k * FOXN + 4096 + h] * KIN(F, 12)[(2 * j + 1) * D + k]); }
}
__device__ __forceinline__ f32x4 load_rs(const Frame& F, const float* xs, int pm) {
    f32x4 a = (f32x4){1.f, 0.f, 0.f, 0.f};
    if (F.tid < 256 && pm >= 0) a = *(const f32x4*)(xs + ((size_t)pm * 256 + F.tid) * 4);
    return a;
}
__device__ __forceinline__ float qk_bound(const Frame& F, const float* qg, const float* kg) {
    float a = fabsf(qg[F.lane]), b = fabsf(kg[F.lane]);
#pragma unroll
    for (int off = 1; off < 64; off <<= 1) { a = fmaxf(a, __uint_as_float((unsigned)__builtin_amdgcn_ds_bpermute(4 * (F.lane ^ off), (int)__float_as_uint(a)))); b = fmaxf(b, __uint_as_float((unsigned)__builtin_amdgcn_ds_bpermute(4 * (F.lane ^ off), (int)__float_as_uint(b)))); }
    return __uint_as_float((unsigned)__builtin_amdgcn_readfirstlane((int)__float_as_uint(64.0f * a * b * attn_body::C2 * 1.02f + 1.0f)));
}
__device__ __forceinline__ void flogit_prestep(const Frame& F, const bf16* XN, const bf16* WF, const float* xs, const float* bfv, float* logf) {
    const int gw = F.vcu * NWAVES + F.wave, NGW = F.G * NWAVES, fr = F.lane & 15, fq = F.lane >> 4;
    for (int task = F.vcu + F.G * F.wave; task < M / 16; task += NGW) { const int r0 = 16 * (128 * ((task >> 5) & 7) + (task & 31) + 32 * (task >> 8));
        const bf16* ap = XN + (size_t)(r0 + fr) * D + 8 * fq; const bf16* bp = WF + (size_t)fr * D + 8 * fq;
        f32x4 acc = (f32x4){0.f, 0.f, 0.f, 0.f};
#pragma unroll 8
        for (int ks = 0; ks < 32; ++ks) { const bf16x8 a = *(const bf16x8*)(ap + 32 * ks), b = *(const bf16x8*)(bp + 32 * ks); acc = __builtin_amdgcn_mfma_f32_16x16x32_bf16(a, b, acc, 0, 0, 0); }
        const float bh = bfv[fr]; f32x4 lf;
#pragma unroll
        for (int e = 0; e < 4; ++e) { const f32x4 a = *(const f32x4*)(xs + (size_t)(r0 + 4 * fq + e) * 4);
            const float tot = (a[0] + a[1]) + (a[2] + a[3]);
            const float z = acc[e] / sqrtf(tot * (1.0f / D) + RMS_EPS) + bh; lf[e] = fminf(z, 0.f) - 0.6931471805599453f * __builtin_amdgcn_logf(1.0f + __builtin_amdgcn_exp2f(-1.4426950408889634f * fabsf(z))); }
        const int row = r0 + 4 * fq;
        *(f32x4*)(logf + ((size_t)((row >> 11) * 16 + fr)) * SEQ + (row & (SEQ - 1))) = lf;
    }
}
__device__ __forceinline__ void spatial_phase(const Frame& F, bf16* Z, const float* stats, const float* lng, const float* lnb, const float* ws, const float* bs, bool do_store = true) {
    constexpr int LST = 272;
    LAS unsigned char* Wl = F.lds; LAS unsigned char* Vt = F.lds + 128 * LST; LAS float* st = (LAS float*)(F.lds + 128 * LST + 256 * LST);
    const int tid = F.tid, lane = F.lane, w = F.wave, fr = lane & 15, fq = lane >> 4;
    int staged_g = -1;
    for (int unit = F.vcu; unit < (M / 128) * 8; unit += F.G) {
        const int g = unit & 7, chunk = 16 * ((unit >> 5) & 7) + ((unit & 31) >> 3) + 4 * (unit >> 8); const size_t row0 = (size_t)chunk * 128;
        f32x4 sq[16];
        if (tid < 128) { const f32x4* sp = (const f32x4*)(stats + (row0 + tid) * 64);
#pragma unroll
            for (int i = 0; i < 16; ++i) sq[i] = sp[i]; }
        const bf16* va = Z + (row0 + 2 * lane) * 4096 + 2048 + 256 * g + 32 * w;
        v4u rawA[4], rawB[4];
#pragma unroll
        for (int it = 0; it < 4; ++it) { rawA[it] = *(const v4u*)(va + 8 * it); rawB[it] = *(const v4u*)(va + 4096 + 8 * it); }
        v2u uu[8][2];
#pragma unroll
        for (int m = 0; m < 8; ++m)
#pragma unroll
            for (int n = 0; n < 2; ++n) uu[m][n] = *(const v2u*)(Z + (row0 + 16 * m + fr) * 4096 + 256 * g + 32 * w + 16 * n + 4 * fq);
        if (tid < 128) { float s1 = 0.f, s2 = 0.f;
#pragma unroll
            for (int i = 0; i < 16; ++i) { const f32x4 q = sq[i]; s1 += q.x + q.z; s2 += q.y + q.w; }
            const float mean = s1 * (1.0f / GE); const float var = fmaxf(s2 * (1.0f / GE) - mean * mean, 0.f);
            st[2 * tid] = mean; st[2 * tid + 1] = 1.0f / sqrtf(var + LN_EPS); }
        if (g != staged_g) { staged_g = g; const float* wg = ws + (size_t)g * 128 * 128;
#pragma unroll
            for (int i = 0; i < 8; ++i) { const int p = tid + 512 * i, t = p >> 5, s4 = (p & 31) * 4; f32x4 x = *(const f32x4*)(wg + t * 128 + s4);
                if (s4 + 0 > t) x.x = 0.f; if (s4 + 1 > t) x.y = 0.f; if (s4 + 2 > t) x.z = 0.f; if (s4 + 3 > t) x.w = 0.f;
                *(LAS v2u*)(Wl + t * LST + s4 * 2) = (v2u){pk2(x.x, x.y), pk2(x.z, x.w)}; } }
        __syncthreads();
        {
            const float meanA = st[4 * lane], rstdA = st[4 * lane + 1], meanB = st[4 * lane + 2], rstdB = st[4 * lane + 3];
#pragma unroll
            for (int it = 0; it < 4; ++it) { const int c0 = 32 * w + 8 * it;
                const f32x4 ga = *(const f32x4*)(lng + 256 * g + c0), gb = *(const f32x4*)(lng + 256 * g + c0 + 4), ba = *(const f32x4*)(lnb + 256 * g + c0), bb = *(const f32x4*)(lnb + 256 * g + c0 + 4);
                const float lg[8] = {ga.x, ga.y, ga.z, ga.w, gb.x, gb.y, gb.z, gb.w}, lb[8] = {ba.x, ba.y, ba.z, ba.w, bb.x, bb.y, bb.z, bb.w};
#pragma unroll
                for (int e = 0; e < 8; ++e) { const unsigned wa = rawA[it][e >> 1], wb = rawB[it][e >> 1]; const float xa = (e & 1) ? bfhi(wa) : bflo(wa), xb = (e & 1) ? bfhi(wb) : bflo(wb);
                    const float ya = (xa - meanA) * rstdA * lg[e] + lb[e], yb = (xb - meanB) * rstdB * lg[e] + lb[e];
                    *(LAS unsigned*)(Vt + (c0 + e) * LST + 4 * lane) = pk2(ya, yb); } } }
        __syncthreads();
        f32x4 acc[8][2];
#pragma unroll
        for (int m = 0; m < 8; ++m) { acc[m][0] = (f32x4){0.f, 0.f, 0.f, 0.f}; acc[m][1] = (f32x4){0.f, 0.f, 0.f, 0.f}; }
#pragma unroll
        for (int ks = 0; ks < 4; ++ks) { bf16x8 Bf[2];
#pragma unroll
            for (int n = 0; n < 2; ++n) Bf[n] = *(const LAS bf16x8*)(Vt + (32 * w + 16 * n + fr) * LST + (ks * 32 + fq * 8) * 2);
#pragma unroll
            for (int m = 0; m < 8; ++m) if (32 * ks <= 16 * m + 15) { const bf16x8 Af = *(const LAS bf16x8*)(Wl + (16 * m + fr) * LST + (ks * 32 + fq * 8) * 2);
#pragma unroll
                for (int n = 0; n < 2; ++n) acc[m][n] = __builtin_amdgcn_mfma_f32_16x16x32_bf16(Bf[n], Af, acc[m][n], 0, 0, 0); } }
#pragma unroll
        for (int m = 0; m < 8; ++m) { const int t = 16 * m + fr; const float b = bs[g * 128 + t];
#pragma unroll
            for (int n = 0; n < 2; ++n) { const int c = 32 * w + 16 * n + 4 * fq; v2u* p = (v2u*)(Z + (row0 + t) * 4096 + 256 * g + c); const v2u u2 = uu[m][n];
                const float o0 = bflo(u2.x) * (acc[m][n][0] + b), o1 = bfhi(u2.x) * (acc[m][n][1] + b), o2 = bflo(u2.y) * (acc[m][n][2] + b), o3 = bfhi(u2.y) * (acc[m][n][3] + b);
                if (do_store) *p = (v2u){pk2(o0, o1), pk2(o2, o3)}; } }
        __syncthreads();
    }
}
#define XB_TMO      128
#define XB_XCNT(j)  (256  + 64 * (j))
#define XB_XSUB(j)  (1280 + 64 * (j))
#define XB_XGEN(j)  (2304 + 64 * (j))
#define XB_TOP      3328
#define XB_TOPGEN   3392
#define XCD_BAR_WORDS 3456
#define XB_SPIN_CAP (1u << 18)

__device__ __forceinline__ unsigned xb_ld(unsigned* p)              { return __hip_atomic_load(p, __ATOMIC_RELAXED, __HIP_MEMORY_SCOPE_AGENT); }
__device__ __forceinline__ unsigned xb_add(unsigned* p, unsigned v) { return __hip_atomic_fetch_add(p, v, __ATOMIC_RELAXED, __HIP_MEMORY_SCOPE_AGENT); }
__device__ __forceinline__ unsigned xb_xcc_id() { return (unsigned)__builtin_amdgcn_s_getreg((3 << 11) | 20) & 0xFu; }
#define XB_SPIN(cond, bar) do { unsigned _sp = 0; while (cond) { __builtin_amdgcn_s_sleep(1); \
    if ((++_sp & 255u) == 0u) { if (xb_ld(&(bar)[XB_TMO])) break; if (_sp > XB_SPIN_CAP) { atomicAdd(&(bar)[XB_TMO], 1u); break; } } } } while (0)

struct XcdBarrier {
    unsigned* bar; unsigned x;
    volatile LAS unsigned* st;
};

__device__ __forceinline__ XcdBarrier xcd_barrier_post(unsigned* bar, volatile LAS unsigned* st) {
    XcdBarrier b; b.bar = bar; b.x = xb_xcc_id(); b.st = st;
    if (threadIdx.x == 0) st[3] = xb_add(&bar[XB_XCNT(b.x)], 1u);
    return b;
}
__device__ __forceinline__ void xcd_barrier_complete(unsigned* bar, unsigned x, unsigned& nloc, unsigned& nx, unsigned& uni) {
    const unsigned G = gridDim.x * gridDim.y * gridDim.z;
    unsigned sum, cnt, mine, sp = 0u;
    for (;;) {
        sum = 0u; cnt = 0u; mine = 0u;
#pragma unroll
        for (unsigned j = 0; j < 16; ++j) { const unsigned c = xb_ld(&bar[XB_XCNT(j)]); sum += c; cnt += (c > 0u) ? 1u : 0u; mine = (j == x) ? c : mine; }
        if (sum == G) break;
        __builtin_amdgcn_s_sleep(1);
        if ((++sp & 255u) == 0u) { if (xb_ld(&bar[XB_TMO])) break; if (sp > XB_SPIN_CAP) { atomicAdd(&bar[XB_TMO], 1u); break; } }
    }
    nloc = mine > 0u ? mine : 1u; nx = cnt > 0u ? cnt : 1u;
    unsigned ok = (sum == G && G == 256u && cnt == 8u) ? 1u : 0u, rank = 0u;
#pragma unroll
    for (unsigned j = 0; j < 16; ++j) { const unsigned c = xb_ld(&bar[XB_XCNT(j)]); if (c != 0u && c != 32u) ok = 0u; if (j < x && c > 0u) ++rank; }
    uni = ok ? 1u + rank : 0u;
}

__device__ __forceinline__ void xcd_barrier(const XcdBarrier& b, const bool local_only = false) {
    asm volatile("s_waitcnt vmcnt(0)" ::: "memory");
    __syncthreads();
    if (threadIdx.x == 0) {
        unsigned* bar = b.bar;
        __builtin_amdgcn_s_waitcnt(0);
        unsigned nloc = b.st[0], nx = b.st[1];
        if (nloc == 0u) { unsigned uni; xcd_barrier_complete(bar, b.x, nloc, nx, uni); b.st[0] = nloc; b.st[1] = nx; b.st[2] = uni; }
        const unsigned old = xb_add(&bar[XB_XSUB(b.x)], 1u);
        const unsigned gen = old / nloc;
        if (old + 1u == (gen + 1u) * nloc) {
            if (!local_only) {
            __builtin_amdgcn_fence(__ATOMIC_RELEASE, "agent");
            asm volatile("s_waitcnt vmcnt(0)" ::: "memory");
            const unsigned og = xb_add(&bar[XB_TOP], 1u);
            const unsigned tg = og / nx;
            if (og + 1u == (tg + 1u) * nx) xb_add(&bar[XB_TOPGEN], 1u);
            else XB_SPIN(xb_ld(&bar[XB_TOPGEN]) == tg, bar);
            }
            __builtin_amdgcn_fence(__ATOMIC_ACQUIRE, "agent");
            xb_add(&bar[XB_XGEN(b.x)], 1u);
            asm volatile("s_waitcnt vmcnt(0)" ::: "memory");
        } else {
            XB_SPIN(xb_ld(&bar[XB_XGEN(b.x)]) == gen, bar);
            __builtin_amdgcn_fence(__ATOMIC_ACQUIRE, "agent");
            asm volatile("s_waitcnt vmcnt(0)" ::: "memory");
        }
    }
    __syncthreads();
}
constexpr int CW_BAR = 1024;
struct Args { const float* in[16]; float* out; unsigned char* ws; int ph_lo, ph_hi; };
__global__ void __launch_bounds__(NWAVES * 64, 2) mk_fwd(Args args) {
    extern __shared__ __attribute__((aligned(16))) unsigned char lds[];
    Frame F; F.lds = (LAS unsigned char*)lds; F.wave = __builtin_amdgcn_readfirstlane((int)threadIdx.x >> 6); F.lane = 0; F.tid = 0; relaunder(F);
    F.G = gridDim.x; { const int bx = blockIdx.x; F.vcu = (F.G % 8 == 0) ? (bx % 8) * (F.G / 8) + bx / 8 : bx; } F.cid = (int)blockIdx.x;
    F.kp = (kptr_t)__builtin_amdgcn_kernarg_segment_ptr();
    volatile LAS unsigned* bst = (volatile LAS unsigned*)(F.lds + 131072);
    if (F.tid == 0) { bst[0] = 0u; bst[1] = 0u; bst[2] = 0u; bst[3] = 0u; }
    __syncthreads();
    XcdBarrier bar; bar.bar = (unsigned*)(KWS(F) + WS_CTL) + CW_BAR; bar.x = 0; bar.st = bst;
    if (args.ph_hi - args.ph_lo > 1) bar = xcd_barrier_post((unsigned*)(KWS(F) + WS_CTL) + CW_BAR, bst);
    const int lo = args.ph_lo, hi = args.ph_hi; int ph = 0;
    if (hi - lo > 1) cg::this_grid().sync();
#define REP(n) for (int rep_ = 0; rep_ < (n); ++rep_)
#define ws KWS(F)
#define out KOUT(F)
#define stats ((float*)(KWS(F) + WS_STATS))
#define logf ((float*)(KWS(F) + WS_LOGF))
#define XN ((bf16*)(KWS(F) + WS_XN))
#define BIG ((bf16*)(KWS(F) + WS_BIG))
#define xs ((float*)(KWS(F) + WS_XS))
#define IN_PH() (lo <= ph && ph < hi && relaunder(F))
#define END_PH() do { if (ph + 1 < hi) { bar.bar = (unsigned*)(KWS(F) + WS_CTL) + CW_BAR; xcd_barrier(bar, xlocal); } } while (0)
    bool xlocal = false;
    if (IN_PH()) { REP(RP_P0) { p0_prologue(F, KWS(F)); p0_rows(F, KWS(F)); } END_PH(); } ++ph;
    if (hi - lo > 1 && lo == 0) { const unsigned uni = __builtin_amdgcn_readfirstlane(bst[2]), lidx = __builtin_amdgcn_readfirstlane(bst[3]);
        if (uni != 0u && lidx < 32u) { xlocal = true; F.vcu = (int)((uni - 1u) * 32u + lidx); F.cid = (int)(lidx * 8u + (uni - 1u)); } }
    if (hi - lo > 1) { REP(RP_BAR) { bar.bar = (unsigned*)(KWS(F) + WS_CTL) + CW_BAR; xcd_barrier(bar); } }
    for (int L = 0; L < 4; ++L) {
        const int j = L >> 1; const bool fox = (L & 1) != 0;
        if (!fox) {
            if (IN_PH()) { pg8::Gemm g{XN, (const bf16*)(ws + WS_WIN_G + j * 8 * MiB), M, 4096, D, D, 0}; pg8::StaticOrder S; S.init(M, 4096, F.G, F.cid); pg8::Unit u0_; const int pm0_ = S.next(0, u0_) ? u0_.pm : -1; const f32x4 rsr_ = load_rs(F, xs, pm0_);
                pg8::EpiBf16<1> E{BIG, 4096, 0, 0, stats, 8, xs, (const LAS float*)(F.lds + 131072 + 8704), pm0_, rsr_, (LAS float*)(F.lds + 131072 + 8704)};
                REP(RP_G4) pg8::gemm_phase<pg8::EpiBf16<1>, pg8::StaticOrder, PG8_ALIGN, PG8_SP2>(F.lds, g, S, E, F.tid); END_PH(); } ++ph;
            if (IN_PH()) { REP(RP_SP) spatial_phase(F, BIG, stats, KIN(F, 2) + j * GE, KIN(F, 3) + j * GE, KIN(F, 4) + (size_t)j * 8 * 128 * 128, KIN(F, 5) + j * 8 * 128, rep_ + lo >= RP_SP - 1); END_PH(); } ++ph;
            if (IN_PH()) { pg8::Gemm g{BIG, (const bf16*)(ws + WS_WOUT_G + j * 4 * MiB), M, D, GE, 4096, 0}; pg8::StaticOrder S; S.init(M, D, F.G, F.cid);
                { pg8::EpiRes E{(const float*)nullptr, (float*)nullptr, XN, xs, D, (LAS float*)(F.lds + 131072 + 256)}; pg8::gemm_phase<pg8::EpiRes, pg8::StaticOrder, true, PG8_SP2>(F.lds, g, S, E, F.tid); } END_PH(); } ++ph;
        } else {
            bf16* Qb = BIG; bf16* Kb = BIG + (size_t)SEQ * D; bf16* Vb = BIG + 2 * (size_t)SEQ * D; bf16* Gb = BIG + 3 * (size_t)SEQ * D;
            if (IN_PH()) { flogit_prestep(F, XN, (const bf16*)(ws + WS_WF) + (size_t)j * 16 * D, xs, KIN(F, 8) + j * 16, logf);
                pg8::Gemm g{XN, (const bf16*)(ws + WS_WIN_F + j * 8 * MiB), M, 4096, D, D, 0}; pg8::StaticOrder S; S.init(M, 4096, F.G, F.cid); pg8::Unit u0_; const int pm0_ = S.next(0, u0_) ? u0_.pm : -1; const f32x4 rsr_ = load_rs(F, xs, pm0_);
                pg8::EpiQKVG E{BIG, D, (size_t)SEQ * D, xs, KIN(F, 9) + j * 64, KIN(F, 10) + j * 64, (LAS float*)(F.lds + 131072 + 256), attn_body::C2, (const LAS float*)(F.lds + 131072 + 8704), pm0_, (size_t)3 * SEQ * D, rsr_, (LAS float*)(F.lds + 131072 + 8704)};
                REP(RP_G4) pg8::gemm_phase<pg8::EpiQKVG, pg8::StaticOrder, true, PG8_SP2>(F.lds, g, S, E, F.tid); END_PH(); } ++ph;
            if (IN_PH()) { const attn_body::AttnTensors AT{(const attn_body::bf16*)Qb, (const attn_body::bf16*)Kb, (const attn_body::bf16*)Vb, (attn_body::bf16*)Qb, (const attn_body::bf16*)Gb, logf, qk_bound(F, KIN(F, 9) + j * 64, KIN(F, 10) + j * 64)};
                const attn_body::StaticOrder S(F.G, F.vcu);
                attn_body::attn_phase<attn_body::StaticOrder>((char*)lds, AT, S, F.tid); END_PH(); } ++ph;
            if (IN_PH()) { pg8::Gemm g{Qb, (const bf16*)(ws + WS_WOUT_F + j * 2 * MiB), M, D, D, D, (size_t)3 * SEQ * D * 2};     pg8::StaticOrder S; S.init(M, D, F.G, F.cid);
                { pg8::EpiRes E{(const float*)nullptr, (float*)nullptr, XN, xs, D, (LAS float*)(F.lds + 131072 + 256)}; pg8::gemm_phase<pg8::EpiRes, pg8::StaticOrder, true, PG8_SP2>(F.lds, g, S, E, F.tid); } END_PH(); } ++ph;
        }
        if (IN_PH()) { pg8::Gemm g{XN, (const bf16*)(ws + WS_W1 + L * 8 * MiB), M, FF, D, D, 0}; pg8::StaticOrder S; S.init(M, FF, F.G, F.cid); pg8::Unit u0_; const int pm0_ = S.next(0, u0_) ? u0_.pm : -1; const f32x4 rsr_ = load_rs(F, xs, pm0_);
            pg8::EpiBf16<2> E{BIG, FF, 0, 0, nullptr, 0, xs, (const LAS float*)(F.lds + 131072 + 8704), pm0_, rsr_, (LAS float*)(F.lds + 131072 + 8704)};
            REP(RP_G4) pg8::gemm_phase<pg8::EpiBf16<2>, pg8::StaticOrder, PG8_ALIGN, PG8_SP2>(F.lds, g, S, E, F.tid); END_PH(); } ++ph;
        if (IN_PH()) { pg8::Gemm g{BIG, (const bf16*)(ws + WS_W2 + L * 8 * MiB), M, D, FF, FF, 0}; pg8::StaticOrder S; S.init(M, D, F.G, F.cid);
            { pg8::EpiRes E{(const float*)nullptr, (L == 3) ? out : (float*)nullptr, XN, xs, D, (LAS float*)(F.lds + 131072 + 256)}; pg8::gemm_phase<pg8::EpiRes, pg8::StaticOrder, true, PG8_SP2>(F.lds, g, S, E, F.tid); } END_PH(); } ++ph;
    }
#undef IN_PH
#undef ws
#undef out
#undef stats
#undef logf
#undef XN
#undef BIG
#undef xs
#undef END_PH
}

extern "C" void kernel_launch(void* const* d_in, const int* in_sizes, int n_in, void* d_out, int out_size, void* d_ws, size_t ws_size, hipStream_t stream) {
    static int grid = 0;
    if (grid == 0) {
        if (n_in != 16 || out_size != M * D || ws_size < WS_END) { fprintf(stderr, "kernel_launch: unexpected shapes: n_in %d out %d ws %zu (need %zu)\n", n_in, out_size, ws_size, (size_t)WS_END); grid = -1; return; }
        int dev = 0, cus = 0, per_cu = 0;
        if (hipGetDevice(&dev) != hipSuccess || hipDeviceGetAttribute(&cus, hipDeviceAttributeMultiprocessorCount, dev) != hipSuccess) { grid = -1; return; }
        if (hipFuncSetAttribute((const void*)mk_fwd, hipFuncAttributeMaxDynamicSharedMemorySize, LDS_BYTES) != hipSuccess) { fprintf(stderr, "kernel_launch: hipFuncSetAttribute failed\n"); grid = -1; return; }
        if (hipOccupancyMaxActiveBlocksPerMultiprocessor(&per_cu, (const void*)mk_fwd, NWAVES * 64, LDS_BYTES) != hipSuccess || per_cu < 1) { fprintf(stderr, "kernel_launch: occupancy query says %d blocks/CU\n", per_cu); per_cu = 1; }
        (void)hipGetLastError();
        grid = cus;
    }
    if (grid < 0) return;
    if (hipMemsetAsync((char*)d_ws + WS_CTL, 0, 65536, stream) != hipSuccess) { fprintf(stderr, "kernel_launch: hipMemsetAsync failed\n"); return; }
    Args a{};
    for (int i = 0; i < 16; ++i) a.in[i] = (const float*)d_in[i];
    a.out = (float*)d_out; a.ws = (unsigned char*)d_ws;
#if MK_ONE_LAUNCH
    a.ph_lo = 0; a.ph_hi = NPHASES;
    void* params[] = {&a};
    hipError_t e = hipLaunchCooperativeKernel((const void*)mk_fwd, dim3(grid), dim3(NWAVES * 64), params, LDS_BYTES, stream);
    if (e != hipSuccess) fprintf(stderr, "kernel_launch: cooperative launch failed: %s (grid %d)\n", hipGetErrorString(e), grid);
#else
    for (int p = 0; p < NPHASES; ++p) { a.ph_lo = p; a.ph_hi = p + 1; hipLaunchKernelGGL(mk_fwd, dim3(grid), dim3(NWAVES * 64), LDS_BYTES, stream, a); }
#endif
}
```
